# Optimizing an MI355X kernel written in HIP

```python
import math
import jax, jax.numpy as jnp
from jax import lax
import numpy as np

D_MODEL = 1024
BATCH = 8
SEQ = 4096
DEPTH = 2

N_MIXERS = 4
GROUP_WIDTH = D_MODEL // N_MIXERS
HEAD_DIM = 64
BLOCK = 128
N_META = 16
SWA_HEADS = GROUP_WIDTH // HEAD_DIM
SWA_KV_HEADS = SWA_HEADS // 2
SWA_GROUP = SWA_HEADS // SWA_KV_HEADS
SWA_WINDOW = 128
DIFF_HEADS = GROUP_WIDTH // HEAD_DIM
DIFF_V_DIM = HEAD_DIM
DIFF_QK_DIM = HEAD_DIM // 2
RWKV_HEADS = GROUP_WIDTH // HEAD_DIM
RWKV_HEAD_SIZE = HEAD_DIM
DECAY_LORA = 64
AAA_LORA = 64
GATE_LORA = 128
CONV_CH = GROUP_WIDTH
CONV_WIDTH = 31
CONV_NORM_GROUPS = 4
REL_BUCKETS = 32
REL_MAX_DIST = 128
N_EXPERTS = 16
N_EXPERT_GROUPS = 4
EXPERTS_PER_GROUP = N_EXPERTS // N_EXPERT_GROUPS
TOP_K = 2
EXPERT_FF = 512
ALPHA = (2 * DEPTH) ** 0.25
BETA = (8 * DEPTH) ** -0.25
SWA_IN = (SWA_HEADS + 2 * SWA_KV_HEADS) * HEAD_DIM
DIFF_IN = 2 * DIFF_HEADS * 2 * DIFF_QK_DIM + DIFF_HEADS * DIFF_V_DIM
RWKV_IN = 3 * GROUP_WIDTH + DECAY_LORA + AAA_LORA + GATE_LORA
CONV_IN = 2 * CONV_CH
IN_WIDTH = SWA_IN + DIFF_IN + RWKV_IN + CONV_IN
NEG = -1e30

kernel_name = "hybrid_swa_diff_rwkv7_conformer_moe"


def _split(u, widths):
    cuts = [int(c) for c in np.cumsum(widths)[:-1]]
    return jnp.split(u, cuts, axis=-1)


def _layernorm(x, g, b, eps=1e-5):
    xf = x.astype(jnp.float32)
    mu = jnp.mean(xf, -1, keepdims=True)
    var = jnp.mean(jnp.square(xf - mu), -1, keepdims=True)
    return ((xf - mu) * lax.rsqrt(var + eps) * g + b).astype(x.dtype)


def _groupnorm(x, n_groups, g, b, eps):
    shp = x.shape
    xf = x.astype(jnp.float32).reshape(shp[:-1] + (n_groups, shp[-1] // n_groups))
    mu = jnp.mean(xf, -1, keepdims=True)
    var = jnp.mean(jnp.square(xf - mu), -1, keepdims=True)
    y = ((xf - mu) * lax.rsqrt(var + eps)).reshape(shp)
    return (y * g + b).astype(x.dtype)


def _t5_bucket(dist):
    n = jnp.maximum(dist, 0)
    max_exact = REL_BUCKETS // 2
    log_ratio = jnp.log(jnp.maximum(n, 1).astype(jnp.float32) / max_exact) / math.log(REL_MAX_DIST / max_exact)
    large = jnp.minimum(max_exact + (log_ratio * (REL_BUCKETS - max_exact)).astype(jnp.int32), REL_BUCKETS - 1)
    return jnp.where(n < max_exact, n, large)


def _swa_attention(q, k, v, sinks, rel_bias_a):
    b, l = q.shape[:2]
    pad = BLOCK - N_META
    nb = (l + pad) // BLOCK

    def blocks(t):
        t = jnp.pad(t, ((0, 0), (pad, 0)) + ((0, 0),) * (t.ndim - 2))
        return t.reshape((b, nb, BLOCK) + t.shape[2:])

    qb = blocks(q).reshape(b, nb, BLOCK, SWA_KV_HEADS, SWA_GROUP, HEAD_DIM)

    def keys_of(t):
        tb = blocks(t)
        prev = jnp.pad(tb, ((0, 0), (1, 0), (0, 0), (0, 0), (0, 0)))[:, :-1]
        meta = jnp.broadcast_to(t[:, None, :N_META], (b, nb, N_META) + t.shape[2:])
        return jnp.concatenate([meta, prev, tb], axis=2)

    kw, vw = keys_of(k), keys_of(v)
    n_keys = N_META + 2 * BLOCK
    qpos = jnp.arange(nb * BLOCK).reshape(nb, BLOCK) - pad
    kpos = jnp.concatenate([jnp.broadcast_to(jnp.arange(N_META), (nb, N_META)), qpos - BLOCK, qpos], axis=1)
    dq = qpos[:, :, None] - kpos[:, None, :]
    is_meta_slot = (jnp.arange(n_keys) < N_META)[None, None, :]
    band_ok = (kpos[:, None, :] >= N_META) & (dq < SWA_WINDOW)
    mask = (dq >= 0) & (is_meta_slot | band_ok)
    bias = jnp.moveaxis(rel_bias_a[_t5_bucket(dq)], -1, 1)
    bias = bias.reshape(nb, SWA_KV_HEADS, SWA_GROUP, BLOCK, n_keys).astype(jnp.float32)
    s = jnp.einsum('bnqhgd,bnkhd->bnhgqk', qb, kw).astype(jnp.float32) * (HEAD_DIM ** -0.5) + bias[None]
    s = jnp.where(mask[None, :, None, None], s, NEG)
    sink = jnp.broadcast_to(sinks.astype(jnp.float32).reshape(1, 1, SWA_KV_HEADS, SWA_GROUP, 1, 1), s.shape[:-1] + (1,))
    p = jax.nn.softmax(jnp.concatenate([s, sink], axis=-1), axis=-1)[..., :-1]
    o = jnp.einsum('bnhgqk,bnkhd->bnqhgd', p.astype(v.dtype), vw)
    return o.reshape(b, nb * BLOCK, SWA_HEADS * HEAD_DIM)[:, pad:]


def _diff_attention(q, k, v, lam, lam_init, subln_g, rel_bias_b):
    b, l = q.shape[:2]
    pad = BLOCK - N_META
    lp = l + pad
    nb = lp // BLOCK
    padt = lambda t: jnp.pad(t, ((0, 0), (pad, 0)) + ((0, 0),) * (t.ndim - 2))
    qp, kp, vp = padt(q), padt(k), padt(v)
    qblocks = jnp.moveaxis(qp.reshape((b, nb, BLOCK) + q.shape[2:]), 1, 0)
    pos = jnp.arange(lp) - pad
    qpos_blocks = pos.reshape(nb, BLOCK)
    scale = DIFF_QK_DIM ** -0.5

    def one_block(args):
        qblk, qpos = args
        s = jnp.einsum('bqhcd,bkhcd->bhcqk', qblk, kp).astype(jnp.float32) * scale
        dq = qpos[:, None] - pos[None, :]
        bias = jnp.moveaxis(rel_bias_b[_t5_bucket(dq)], -1, 0).astype(jnp.float32)
        s = s + bias[None, :, None]
        mask = (dq >= 0) & (pos >= 0)[None, :]
        p = jax.nn.softmax(jnp.where(mask, s, NEG), axis=-1)
        attn = p[:, :, 0] - lam * p[:, :, 1]
        return jnp.einsum('bhqk,bkhd->bqhd', attn.astype(v.dtype), vp)

    o = lax.map(one_block, (qblocks, qpos_blocks))
    o = jnp.moveaxis(o, 0, 1).reshape(b, lp, DIFF_HEADS, DIFF_V_DIM)[:, pad:]
    of = o.astype(jnp.float32)
    of = of * lax.rsqrt(jnp.mean(jnp.square(of), -1, keepdims=True) + 1e-5) * subln_g * (1.0 - lam_init)
    return of.reshape(b, l, DIFF_HEADS * DIFF_V_DIM).astype(v.dtype)


def _rwkv7_mix(uc, mu, w0, w2, a0, a2, g2, k_k, k_a, r_k, lnx_g, lnx_b):
    b, l, _ = uc.shape
    f32 = jnp.float32
    prev = jnp.pad(uc, ((0, 0), (1, 0), (0, 0)))[:, :-1]
    uc = uc + mu * (prev - uc)
    r, k, v, xw, xa, xg = _split(uc, (GROUP_WIDTH, GROUP_WIDTH, GROUP_WIDTH, DECAY_LORA, AAA_LORA, GATE_LORA))
    w = jnp.exp(-math.exp(-0.5) * jax.nn.sigmoid((w0 + jnp.tanh(xw) @ w2).astype(f32)))
    a = jax.nn.sigmoid((a0 + xa @ a2).astype(f32))
    g = jax.nn.sigmoid(xg) @ g2
    k = k.astype(f32)
    heads = lambda t: t.reshape(b, l, RWKV_HEADS, RWKV_HEAD_SIZE)
    kk = heads(k * k_k)
    kk = kk / jnp.maximum(jnp.sqrt(jnp.sum(jnp.square(kk), -1, keepdims=True)), 1e-12)
    k = k * (1.0 + (a - 1.0) * k_a)
    r_h, w_h, k_h, v_h, a_h = heads(r.astype(f32)), heads(w), heads(k), heads(v.astype(f32)), heads(a)

    def step(S, inp):
        r_t, w_t, k_t, v_t, kk_t, a_t = inp
        sa = jnp.einsum('bhij,bhj->bhi', S, -kk_t)
        S = S * w_t[:, :, None, :] + sa[..., None] * (kk_t * a_t)[:, :, None, :] + v_t[..., None] * k_t[:, :, None, :]
        return S, jnp.einsum('bhij,bhj->bhi', S, r_t)

    S0 = jnp.zeros((b, RWKV_HEADS, RWKV_HEAD_SIZE, RWKV_HEAD_SIZE), f32)
    xs = tuple(jnp.moveaxis(t, 1, 0) for t in (r_h, w_h, k_h, v_h, kk, a_h))
    _, ys = lax.scan(step, S0, xs)
    y = jnp.moveaxis(ys, 0, 1).reshape(b, l, GROUP_WIDTH)
    y = _groupnorm(y, RWKV_HEADS, lnx_g, lnx_b, 64e-5)
    bonus = (jnp.sum(r_h * k_h * r_k, -1, keepdims=True) * v_h).reshape(b, l, GROUP_WIDTH)
    return ((y + bonus) * g).astype(uc.dtype)


def _conv_module(ud, conv_w, conv_b, gn_g, gn_b):
    a, gate = jnp.split(ud, 2, axis=-1)
    h = a * jax.nn.sigmoid(gate)
    h = lax.conv_general_dilated(h, conv_w[:, None, :], window_strides=(1,),
                                 padding=[(CONV_WIDTH - 1, 0)],
                                 dimension_numbers=('NWC', 'WIO', 'NWC'),
                                 feature_group_count=CONV_CH) + conv_b
    h = _groupnorm(h, CONV_NORM_GROUPS, gn_g, gn_b, 1e-5)
    return jax.nn.silu(h)


def _moe(h, router_w, router_b, w1, w3, w2):
    b, l, d = h.shape
    n_tok = b * l
    t = h.reshape(n_tok, d)
    scores = jax.nn.sigmoid((t @ router_w).astype(jnp.float32))
    biased = scores + router_b.astype(jnp.float32)
    grp_top = lax.top_k(biased.reshape(n_tok, N_EXPERT_GROUPS, EXPERTS_PER_GROUP), TOP_K)[0]
    best_group = jnp.argmax(jnp.sum(grp_top, -1), axis=-1)
    in_group = jnp.repeat(jnp.arange(N_EXPERT_GROUPS)[None, :] == best_group[:, None], EXPERTS_PER_GROUP, axis=1)
    _, top_idx = lax.top_k(jnp.where(in_group, biased, NEG), TOP_K)
    top_s = jnp.take_along_axis(scores, top_idx, axis=-1)
    gates = top_s / jnp.sum(top_s, -1, keepdims=True)
    combine = jnp.sum(jax.nn.one_hot(top_idx, N_EXPERTS, dtype=jnp.float32) * gates[..., None], axis=1)
    out = jnp.zeros((n_tok, d), jnp.float32)
    for e in range(N_EXPERTS):
        act = jax.nn.silu(t @ w1[e]) * (t @ w3[e])
        out = out + combine[:, e:e + 1] * (act @ w2[e])
    return out.astype(h.dtype).reshape(b, l, d)


def setup_inputs(seed: int = 0) -> dict:
    key = jax.random.key(seed)
    ks = jax.random.split(key, 40)
    n = lambda i, shp, s=1.0: jax.random.normal(ks[i], shp, jnp.float32) * s
    L = DEPTH
    gw = GROUP_WIDTH
    return {
        "x": n(0, (BATCH, SEQ, D_MODEL)),
        "meta": n(1, (N_META, D_MODEL)),
        "ln0_g": 1.0 + n(2, (D_MODEL,), 0.02),
        "ln0_b": n(3, (D_MODEL,), 0.02),
        "w_in": n(4, (L, D_MODEL, IN_WIDTH), D_MODEL ** -0.5),
        "swa_sinks": n(5, (L, SWA_HEADS), 0.5),
        "rel_bias": n(6, (REL_BUCKETS, SWA_HEADS + DIFF_HEADS), 0.5),
        "diff_lq1": n(7, (L, DIFF_QK_DIM), 0.1),
        "diff_lk1": n(8, (L, DIFF_QK_DIM), 0.1),
        "diff_lq2": n(9, (L, DIFF_QK_DIM), 0.1),
        "diff_lk2": n(10, (L, DIFF_QK_DIM), 0.1),
        "diff_subln_g": 1.0 + n(11, (L, DIFF_V_DIM), 0.02),
        "rwkv_mu": jax.random.uniform(ks[12], (L, RWKV_IN), jnp.float32),
        "rwkv_w0": n(13, (L, gw)),
        "rwkv_w2": n(14, (L, DECAY_LORA, gw), DECAY_LORA ** -0.5),
        "rwkv_a0": n(15, (L, gw), 0.5),
        "rwkv_a2": n(16, (L, AAA_LORA, gw), AAA_LORA ** -0.5),
        "rwkv_g2": n(17, (L, GATE_LORA, gw), GATE_LORA ** -0.5),
        "rwkv_kk": 0.85 + n(18, (L, gw), 0.05),
        "rwkv_ka": 1.0 + n(19, (L, gw), 0.05),
        "rwkv_rk": n(20, (L, RWKV_HEADS, RWKV_HEAD_SIZE), 0.1),
        "rwkv_lnx_g": 1.0 + n(21, (L, gw), 0.02),
        "rwkv_lnx_b": n(22, (L, gw), 0.02),
        "conv_w": n(23, (L, CONV_WIDTH, CONV_CH), CONV_WIDTH ** -0.5),
        "conv_b": n(24, (L, CONV_CH), 0.02),
        "conv_gn_g": 1.0 + n(25, (L, CONV_CH), 0.02),
        "conv_gn_b": n(26, (L, CONV_CH), 0.02),
        "w_out": n(27, (L, D_MODEL, D_MODEL), BETA * D_MODEL ** -0.5),
        "ln1_g": 1.0 + n(28, (L, D_MODEL), 0.02),
        "ln1_b": n(29, (L, D_MODEL), 0.02),
        "router_w": n(30, (D_MODEL, N_EXPERTS), D_MODEL ** -0.5),
        "router_b": n(31, (N_EXPERTS,), 0.01),
        "exp_w1": n(32, (L, N_EXPERTS, D_MODEL, EXPERT_FF), D_MODEL ** -0.5),
        "exp_w3": n(33, (L, N_EXPERTS, D_MODEL, EXPERT_FF), D_MODEL ** -0.5),
        "exp_w2": n(34, (L, N_EXPERTS, EXPERT_FF, D_MODEL), BETA * EXPERT_FF ** -0.5),
        "ln2_g": 1.0 + n(35, (L, D_MODEL), 0.02),
        "ln2_b": n(36, (L, D_MODEL), 0.02),
    }


def reference(x, meta, ln0_g, ln0_b, w_in, swa_sinks, rel_bias, diff_lq1, diff_lk1, diff_lq2, diff_lk2,
              diff_subln_g, rwkv_mu, rwkv_w0, rwkv_w2, rwkv_a0, rwkv_a2, rwkv_g2, rwkv_kk, rwkv_ka, rwkv_rk,
              rwkv_lnx_g, rwkv_lnx_b, conv_w, conv_b, conv_gn_g, conv_gn_b, w_out, ln1_g, ln1_b,
              router_w, router_b, exp_w1, exp_w3, exp_w2, ln2_g, ln2_b):
    b = x.shape[0]
    f32 = jnp.float32
    h = jnp.concatenate([jnp.broadcast_to(meta[None].astype(x.dtype), (b, N_META, D_MODEL)), x], axis=1)
    h = _layernorm(h, ln0_g, ln0_b)
    lt = h.shape[1]
    rel_a = rel_bias[:, :SWA_HEADS]
    rel_b = rel_bias[:, SWA_HEADS:]
    for l in range(DEPTH):
        u = h @ w_in[l]
        ua, ub, uc, ud = _split(u, (SWA_IN, DIFF_IN, RWKV_IN, CONV_IN))
        qa, ka, va = _split(ua, (SWA_HEADS * HEAD_DIM, SWA_KV_HEADS * HEAD_DIM, SWA_KV_HEADS * HEAD_DIM))
        ya = _swa_attention(qa.reshape(b, lt, SWA_HEADS, HEAD_DIM),
                            ka.reshape(b, lt, SWA_KV_HEADS, HEAD_DIM),
                            va.reshape(b, lt, SWA_KV_HEADS, HEAD_DIM), swa_sinks[l], rel_a)
        qd, kd, vd = _split(ub, (DIFF_HEADS * 2 * DIFF_QK_DIM, DIFF_HEADS * 2 * DIFF_QK_DIM, DIFF_HEADS * DIFF_V_DIM))
        lam_init = 0.8 - 0.6 * math.exp(-0.3 * l)
        lam = (jnp.exp(jnp.sum(diff_lq1[l].astype(f32) * diff_lk1[l].astype(f32)))
               - jnp.exp(jnp.sum(diff_lq2[l].astype(f32) * diff_lk2[l].astype(f32))) + lam_init)
        yb = _diff_attention(qd.reshape(b, lt, DIFF_HEADS, 2, DIFF_QK_DIM),
                             kd.reshape(b, lt, DIFF_HEADS, 2, DIFF_QK_DIM),
                             vd.reshape(b, lt, DIFF_HEADS, DIFF_V_DIM), lam, lam_init, diff_subln_g[l], rel_b)
        yc = _rwkv7_mix(uc, rwkv_mu[l], rwkv_w0[l], rwkv_w2[l], rwkv_a0[l], rwkv_a2[l], rwkv_g2[l],
                        rwkv_kk[l], rwkv_ka[l], rwkv_rk[l], rwkv_lnx_g[l], rwkv_lnx_b[l])
        yd = _conv_module(ud, conv_w[l], conv_b[l], conv_gn_g[l], conv_gn_b[l])
        mix = jnp.concatenate([ya, yb.astype(ya.dtype), yc.astype(ya.dtype), yd.astype(ya.dtype)], axis=-1) @ w_out[l]
        h = _layernorm(ALPHA * h + mix, ln1_g[l], ln1_b[l])
        h = _layernorm(ALPHA * h + _moe(h, router_w, router_b, exp_w1[l], exp_w3[l], exp_w2[l]), ln2_g[l], ln2_b[l])
    return h[:, N_META:]
```

```cpp
#include <hip/hip_runtime.h>
#include <stdint.h>
#include <stdio.h>

#ifndef MK_ONE_LAUNCH
#define MK_ONE_LAUNCH 0
#endif

#define LAS __attribute__((address_space(3)))
typedef unsigned short bf16_t;
typedef short bf16x8 __attribute__((ext_vector_type(8)));
typedef float f32x4 __attribute__((ext_vector_type(4)));
typedef float f32x2 __attribute__((ext_vector_type(2)));
typedef unsigned u32x4 __attribute__((ext_vector_type(4)));
typedef unsigned u32x2 __attribute__((ext_vector_type(2)));

constexpr int D = 1024, NB = 8, SEQ = 4096, NMETA = 16, LT = SEQ + NMETA, T = NB * LT  , MP = 33024  ;
constexpr int INW = 2816, NLAYER = 2, NE = 16, FF = 512;
constexpr int NSLOT = 2 * T  , NSLOTP = NSLOT + 256;
constexpr float ALPHA = 1.41421356237f;
constexpr int C_QA = 0, C_KA = 256, C_VA = 384, C_QD = 512, C_KD = 768, C_VD = 1024, C_RW = 1280, C_CA = 2304, C_CG = 2560;
constexpr int M_A = 0, M_B = 256, M_C = 512, M_D = 768;

constexpr size_t AL(size_t x) { return (x + 255) & ~(size_t)255; }
constexpr size_t WS_CTL = 0, CTL_BYTES = 65536;
constexpr size_t WS_HB = WS_CTL + CTL_BYTES;
constexpr size_t WS_U = WS_HB + (size_t)MP * D * 2;
constexpr size_t WS_MIX = WS_U + (size_t)MP * INW * 2;
constexpr size_t WS_WIN = WS_MIX + (size_t)MP * D * 2;
constexpr size_t WS_WOUT = WS_WIN + (size_t)NLAYER * INW * D * 2;
constexpr size_t WS_W13 = WS_WOUT + (size_t)NLAYER * D * D * 2;
constexpr size_t WS_W2 = WS_W13 + (size_t)NLAYER * NE * 1024 * 1024 * 2;
constexpr size_t WS_TOKE = WS_W2 + (size_t)NLAYER * NE * 1024 * FF * 2;
constexpr size_t WS_TOKP = WS_TOKE + AL((size_t)T * 8);
constexpr size_t WS_TOKG = WS_TOKP + AL((size_t)T * 8);
constexpr size_t WS_TOKS = WS_TOKG + AL((size_t)T * 8);
constexpr size_t WS_LIST = WS_TOKS + AL((size_t)T * 8);
constexpr size_t WS_GSL = WS_LIST + AL((size_t)NSLOTP * 4);
constexpr size_t WS_RWB = WS_GSL + AL((size_t)NSLOTP * 4);
constexpr size_t WS_END = WS_RWB + (size_t)4 * T * 256 * 2;
constexpr size_t WS_Z = WS_U;
constexpr size_t WS_ACT = WS_U;
constexpr size_t WS_Y2 = WS_ACT + (size_t)NSLOTP * FF * 2;
static_assert(WS_Y2 + (size_t)NSLOTP * D * 2 <= WS_WIN, "moe alias");
static_assert(WS_END <= (size_t)536870912, "workspace");
constexpr int CW_BAR = 0;
constexpr int CW_CNT = 4096;
static_assert((size_t)3 * T * 256 * 4 <= (size_t)NB * SEQ * D * 4, "rwkv f32 temporaries");

struct Params { const float* in[37]; float* out; unsigned char* ws; };
enum { I_X = 0, I_META, I_LN0G, I_LN0B, I_WIN, I_SINKS, I_RELB, I_LQ1, I_LK1, I_LQ2, I_LK2, I_SUBLN, I_MU, I_W0, I_W2, I_A0, I_A2, I_G2, I_KK, I_KA, I_RK,
       I_LNXG, I_LNXB, I_CONVW, I_CONVB, I_GNG, I_GNB, I_WOUT, I_LN1G, I_LN1B, I_ROUTW, I_ROUTB, I_EW1, I_EW3, I_EW2, I_LN2G, I_LN2B };

__device__ __forceinline__ float bf2f(bf16_t b) { return __uint_as_float(((unsigned)b) << 16); }
__device__ __forceinline__ bf16_t f2bf(float f) { unsigned u = __float_as_uint(f); u += 0x7FFFu + ((u >> 16) & 1u); return (bf16_t)(u >> 16); }
__device__ __forceinline__ unsigned pk2(float lo, float hi) { return (unsigned)f2bf(lo) | ((unsigned)f2bf(hi) << 16); }
__device__ __forceinline__ float bflo(unsigned w) { return __uint_as_float(w << 16); }
__device__ __forceinline__ float bfhi(unsigned w) { return __uint_as_float(w & 0xFFFF0000u); }
__device__ __forceinline__ float wave_sum(float v) {
#pragma unroll
    for (int o = 1; o < 64; o <<= 1) v += __shfl_xor(v, o);
    return v;
}
__device__ __forceinline__ float sigmoidf_(float x) { return 1.0f / (1.0f + __expf(-x)); }
__device__ __forceinline__ int t5_bucket(int n) {
    if (n < 16) return n;
    int b = 16;
    b += (n >= 19); b += (n >= 21); b += (n >= 24); b += (n >= 27); b += (n >= 31); b += (n >= 35); b += (n >= 40); b += (n >= 46);
    b += (n >= 52); b += (n >= 59); b += (n >= 67); b += (n >= 77); b += (n >= 87); b += (n >= 99); b += (n >= 113);
    return b;
}

namespace pg8 {
constexpr int BM = 256, BK = 64, HALF = 128, HTB = HALF * BK * 2, STAGE_BYTES = 8 * HTB, NXCD = 8, WGM = 8;
__host__ __device__ __forceinline__ int lds_byte(int r, int c) { const int st = (r >> 4) * 2 + (c >> 5), rr = r & 15, cc = c & 31, ob = rr * 64 + cc * 2; return st * 1024 + (ob ^ (((ob >> 9) & 1) << 5)); }
__host__ __device__ __forceinline__ void stage_rc(int b, int& R, int& C) { const int st = b / 1024, sb = b % 1024, swz = sb ^ (((sb >> 9) & 1) << 5); R = (st >> 1) * 16 + swz / 64; C = (st & 1) * 32 + (swz % 64) / 2; }
__host__ __device__ __forceinline__ int perm32(int rho) { const int n = rho >> 4, i = rho & 15; return 8 * (i >> 2) + 4 * n + (i & 3); }

struct Unit { int pn, row0, rend, e; };

struct DenseOrder {
    int nM, nN, nwg, G, c, M; const bf16_t* Bt; int K;
    __device__ void init(int M_, int N, int K_, const bf16_t* Bt_, int G_, int c_) { M = M_; nM = M_ / BM; nN = N / BM; nwg = nM * nN; G = G_; c = c_; Bt = Bt_; K = K_; }
    __device__ bool next(int i, Unit& u) const {
        const long L = (long)i * G + c; if (L >= nwg) return false;
        int wgid = (int)L; { const int q = nwg / NXCD, r = nwg % NXCD, xcd = wgid % NXCD, off = wgid / NXCD; wgid = (xcd < r ? xcd * (q + 1) : r * (q + 1) + (xcd - r) * q) + off; }
        const int nig = WGM * nN, gid = wgid / nig, fm = gid * WGM, gsz = (nM - fm) < WGM ? (nM - fm) : WGM;
        u.row0 = (fm + ((wgid % nig) % gsz)) * BM; u.pn = (wgid % nig) / gsz; u.rend = M; u.e = 0; return true;
    }
    __device__ __forceinline__ const char* b_ptr(const Unit& u) const { return (const char*)Bt + (size_t)u.pn * BM * K * 2; }
    __device__ __forceinline__ unsigned a_row(const Unit& u, int r) const { return (unsigned)(u.row0 + r); }
};
struct MoeOrder {
    const LAS int* tab; int nN, G, c; const bf16_t* Bt; size_t bstride; int K; const int* list;
    __device__ bool next(int i, Unit& u) const {
        const long L = (long)i * G + c; const int ntile = tab[16];
        if (L >= (long)ntile * nN) return false;
        const int tile = (int)(L / nN); u.pn = (int)(L % nN);
        int e = 0;
#pragma unroll
        for (int k = 1; k < 16; ++k) e += (tab[k] <= tile) ? 1 : 0;
        u.e = e; u.row0 = tab[17 + e] + (tile - tab[e]) * BM; u.rend = tab[17 + e + 1]; return true;
    }
    __device__ __forceinline__ const char* b_ptr(const Unit& u) const { return (const char*)Bt + ((size_t)u.e * bstride + (size_t)u.pn * BM * K) * 2; }
    __device__ __forceinline__ unsigned a_row(const Unit& u, int r) const { return list ? (unsigned)list[u.row0 + r] : (unsigned)(u.row0 + r); }
};

__device__ __forceinline__ unsigned cvt_pk_bf16(float lo, float hi) { unsigned r; asm volatile("v_cvt_pk_bf16_f32 %0, %1, %2" : "=v"(r) : "v"(lo), "v"(hi)); return r; }

struct EpiBf16 {
    static constexpr bool PERM = true;
    bf16_t* O; int ldc;
    __device__ __forceinline__ void operator()(const f32x4 (&acc)[2][2][4][2], const Unit& u, int wr, int wc, int fr, int fq) const {
        const int row0 = u.row0 + wr * 64 + fr, col0 = u.pn * BM + wc * 32 + 8 * fq;
#pragma unroll
        for (int ai = 0; ai < 2; ++ai)
#pragma unroll
            for (int m = 0; m < 4; ++m) { bf16_t* rowp = O + (size_t)(row0 + ai * HALF + m * 16) * ldc + col0;
#pragma unroll
                for (int bj = 0; bj < 2; ++bj) { const f32x4 v0 = acc[ai][bj][m][0], v1 = acc[ai][bj][m][1];
                    u32x4 w; w.x = cvt_pk_bf16(v0[0], v0[1]); w.y = cvt_pk_bf16(v0[2], v0[3]); w.z = cvt_pk_bf16(v1[0], v1[1]); w.w = cvt_pk_bf16(v1[2], v1[3]);
                    *(u32x4*)(rowp + bj * HALF) = w; } }
    }
};
struct EpiZ {
    static constexpr bool PERM = false;
    float* Z; const bf16_t* hb;
    __device__ __forceinline__ void operator()(const f32x4 (&acc)[2][2][4][2], const Unit& u, int wr, int wc, int fr, int fq) const {
        const int row0 = u.row0 + wr * 64 + fr, col0 = u.pn * BM + wc * 32 + 4 * fq;
#pragma unroll
        for (int ai = 0; ai < 2; ++ai)
#pragma unroll
            for (int m = 0; m < 4; ++m) { const size_t ro = (size_t)(row0 + ai * HALF + m * 16) * D + col0;
#pragma unroll
                for (int bj = 0; bj < 2; ++bj)
#pragma unroll
                    for (int n = 0; n < 2; ++n) { const u32x2 h = *(const u32x2*)(hb + ro + bj * HALF + n * 16);
                        f32x4 v = acc[ai][bj][m][n]; v[0] += ALPHA * bflo(h.x); v[1] += ALPHA * bfhi(h.x); v[2] += ALPHA * bflo(h.y); v[3] += ALPHA * bfhi(h.y);
                        *(f32x4*)(Z + ro + bj * HALF + n * 16) = v; } }
    }
};
struct EpiAct {
    static constexpr bool PERM = true;
    bf16_t* A;
    __device__ __forceinline__ void operator()(const f32x4 (&acc)[2][2][4][2], const Unit& u, int wr, int wc, int fr, int fq) const {
        const int row0 = u.row0 + wr * 64 + fr, col0 = (u.pn * BM + wc * 32 + 8 * fq) >> 1;
#pragma unroll
        for (int ai = 0; ai < 2; ++ai)
#pragma unroll
            for (int m = 0; m < 4; ++m) { const int row = row0 + ai * HALF + m * 16; if (row < u.rend) { bf16_t* rowp = A + (size_t)row * FF + col0;
#pragma unroll
                for (int bj = 0; bj < 2; ++bj) { const f32x4 a = acc[ai][bj][m][0], b = acc[ai][bj][m][1]; float o[4];
#pragma unroll
                    for (int j = 0; j < 4; ++j) o[j] = a[j] / (1.0f + __expf(-a[j])) * b[j];
                    u32x2 w; w.x = cvt_pk_bf16(o[0], o[1]); w.y = cvt_pk_bf16(o[2], o[3]);
                    *(u32x2*)(rowp + bj * (HALF / 2)) = w; } } }
    }
};
struct EpiY2 {
    static constexpr bool PERM = true;
    bf16_t* Y; const float* gate;
    __device__ __forceinline__ void operator()(const f32x4 (&acc)[2][2][4][2], const Unit& u, int wr, int wc, int fr, int fq) const {
        const int row0 = u.row0 + wr * 64 + fr, col0 = u.pn * BM + wc * 32 + 8 * fq;
#pragma unroll
        for (int ai = 0; ai < 2; ++ai)
#pragma unroll
            for (int m = 0; m < 4; ++m) { const int row = row0 + ai * HALF + m * 16; if (row < u.rend) { const float gt = gate[row]; bf16_t* rowp = Y + (size_t)row * D + col0;
#pragma unroll
                for (int bj = 0; bj < 2; ++bj) { const f32x4 v0 = acc[ai][bj][m][0] * gt, v1 = acc[ai][bj][m][1] * gt;
                    u32x4 w; w.x = cvt_pk_bf16(v0[0], v0[1]); w.y = cvt_pk_bf16(v0[2], v0[3]); w.z = cvt_pk_bf16(v1[0], v1[1]); w.w = cvt_pk_bf16(v1[2], v1[3]);
                    *(u32x4*)(rowp + bj * HALF) = w; } } }
    }
};

template <class Epi, class Sched>
__device__ __forceinline__ void gemm_phase(LAS unsigned char* lds, const bf16_t* Abase, const int K, const Sched& S, const Epi& E) {
    const int tid = threadIdx.x, wid = __builtin_amdgcn_readfirstlane(tid >> 6), lane = tid & 63, wr = wid >> 2, wc = wid & 3, fr = lane & 15, fq = lane >> 4;
    const int nt = K / BK;
    int RA[2], CA[2]; unsigned voffB[2];
#pragma unroll
    for (int i = 0; i < 2; ++i) { int R, C; stage_rc(tid * 16 + i * 8192, R, C); const int Rb = Epi::PERM ? ((R & ~31) + perm32(R & 31)) : R;
        RA[i] = R; CA[i] = C; voffB[i] = (unsigned)(Rb * K + C) * 2u; }
    const size_t kstep = (size_t)(BK * 2);
    const size_t hstep = (size_t)HALF * K * 2;
    const unsigned ldsw = (unsigned)wid * 1024u;
    const int aoff = lds_byte(wr * 64 + fr, fq * 8), boff = lds_byte(wc * 32 + fr, fq * 8);
#define PG8_SA(b, h) (((b) * 2 + (h)) * HTB)
#define PG8_SB(b, h) ((4 + (b) * 2 + (h)) * HTB)
#define PG8_STAGE(bufoff, gbase, voff) do { _Pragma("unroll") for (int _i = 0; _i < 2; ++_i) \
        __builtin_amdgcn_global_load_lds((const unsigned*)((const char*)(gbase) + (voff)[_i]), (LAS unsigned*)(lds + (bufoff) + ldsw + _i * 8192), 16, 0, 0); } while (0)
#define PG8_LDA(dst, b, h) do { _Pragma("unroll") for (int m = 0; m < 4; ++m) _Pragma("unroll") for (int k = 0; k < 2; ++k) dst[m][k] = *(const LAS bf16x8*)(lds + PG8_SA(b, h) + aoff + m * 2048 + k * 1024); } while (0)
#define PG8_LDB(dst, b, h) do { _Pragma("unroll") for (int n = 0; n < 2; ++n) _Pragma("unroll") for (int k = 0; k < 2; ++k) dst[n][k] = *(const LAS bf16x8*)(lds + PG8_SB(b, h) + boff + n * 2048 + k * 1024); } while (0)
#define PG8_MMA(ai, bj, At, Bt) do { __builtin_amdgcn_s_setprio(1); _Pragma("unroll") for (int m = 0; m < 4; ++m) _Pragma("unroll") for (int n = 0; n < 2; ++n) _Pragma("unroll") for (int k = 0; k < 2; ++k) \
        acc[ai][bj][m][n] = __builtin_amdgcn_mfma_f32_16x16x32_bf16(Bt[n][k], At[m][k], acc[ai][bj][m][n], 0, 0, 0); __builtin_amdgcn_s_setprio(0); } while (0)
#define PG8_WAIT_V(n) asm volatile("s_waitcnt vmcnt(" #n ")" ::: "memory")
#define PG8_WAIT_L(n) asm volatile("s_waitcnt lgkmcnt(" #n ")" ::: "memory")
#define PG8_BAR __builtin_amdgcn_s_barrier()
#define PG8_SCHED __builtin_amdgcn_sched_barrier(0)
#define PG8_AOFF(u) do { _Pragma("unroll") for (int _h = 0; _h < 2; ++_h) _Pragma("unroll") for (int _i = 0; _i < 2; ++_i) \
        voffA[_h][_i] = (S.a_row(u, _h * HALF + RA[_i]) * (unsigned)K + (unsigned)CA[_i]) * 2u; } while (0)
    Unit cur, nxt; int ui = 0;
    if (!S.next(0, cur)) return;
    f32x4 acc[2][2][4][2];
#pragma unroll
    for (int a = 0; a < 2; ++a)
#pragma unroll
        for (int b = 0; b < 2; ++b)
#pragma unroll
            for (int m = 0; m < 4; ++m)
#pragma unroll
                for (int n = 0; n < 2; ++n) acc[a][b][m][n] = (f32x4){0.f, 0.f, 0.f, 0.f};
    bf16x8 At[4][2], B0[2][2], B1[2][2];
    unsigned voffA[2][2];
    PG8_AOFF(cur);
    const char* Ab = (const char*)Abase;
    const char* cB = S.b_ptr(cur);
    PG8_STAGE(PG8_SB(0, 0), cB, voffB); PG8_STAGE(PG8_SA(0, 0), Ab, voffA[0]); PG8_STAGE(PG8_SB(0, 1), cB + hstep, voffB); PG8_STAGE(PG8_SA(0, 1), Ab, voffA[1]);
    if (wr == 1) PG8_BAR;
    PG8_WAIT_V(4); PG8_BAR;
    PG8_STAGE(PG8_SB(1, 0), cB + kstep, voffB); PG8_STAGE(PG8_SA(1, 0), Ab + kstep, voffA[0]); PG8_STAGE(PG8_SB(1, 1), cB + hstep + kstep, voffB);
    PG8_WAIT_V(6); PG8_BAR;
    for (;;) {
        const bool has_next = S.next(ui + 1, nxt);
        const char* nB = has_next ? S.b_ptr(nxt) : cB;
        for (int t = 0; t < nt; t += 2) {
            const bool last = (t == nt - 2);
            const char* a1 = Ab + (size_t)(t + 1) * kstep;
            PG8_LDB(B0, 0, 0); PG8_SCHED; PG8_LDA(At, 0, 0); PG8_STAGE(PG8_SA(1, 1), a1, voffA[1]);
            PG8_WAIT_L(8); PG8_BAR; PG8_WAIT_L(0); PG8_MMA(0, 0, At, B0); PG8_BAR; PG8_SCHED;
            if (last && has_next) PG8_AOFF(nxt);
            const char* a2 = last ? Ab : Ab + (size_t)(t + 2) * kstep; const char* b2 = last ? nB : cB + (size_t)(t + 2) * kstep;
            const char* a3 = a2 + kstep; const char* b3 = b2 + kstep;
            PG8_LDB(B1, 0, 1); PG8_STAGE(PG8_SB(0, 0), b2, voffB);
            PG8_BAR; PG8_WAIT_L(0); PG8_MMA(0, 1, At, B1); PG8_BAR;
            PG8_LDA(At, 0, 1); PG8_STAGE(PG8_SA(0, 0), a2, voffA[0]);
            PG8_BAR; PG8_WAIT_L(0); PG8_MMA(1, 0, At, B0); PG8_BAR; PG8_SCHED;
            PG8_STAGE(PG8_SB(0, 1), b2 + hstep, voffB);
            PG8_WAIT_V(6); PG8_BAR; PG8_MMA(1, 1, At, B1); PG8_BAR;
            PG8_LDB(B0, 1, 0); PG8_SCHED; PG8_LDA(At, 1, 0); PG8_STAGE(PG8_SA(0, 1), a2, voffA[1]);
            PG8_WAIT_L(8); PG8_BAR; PG8_WAIT_L(0); PG8_MMA(0, 0, At, B0); PG8_BAR; PG8_SCHED;
            PG8_LDB(B1, 1, 1); PG8_STAGE(PG8_SB(1, 0), b3, voffB);
            PG8_BAR; PG8_WAIT_L(0); PG8_MMA(0, 1, At, B1); PG8_BAR;
            PG8_LDA(At, 1, 1); PG8_STAGE(PG8_SA(1, 0), a3, voffA[0]);
            PG8_BAR; PG8_WAIT_L(0); PG8_MMA(1, 0, At, B0); PG8_BAR; PG8_SCHED;
            PG8_STAGE(PG8_SB(1, 1), b3 + hstep, voffB);
            PG8_WAIT_V(6); PG8_BAR; PG8_MMA(1, 1, At, B1); PG8_BAR;
        }
        E(acc, cur, wr, wc, fr, fq);
        if (!has_next) break;
#pragma unroll
        for (int a = 0; a < 2; ++a)
#pragma unroll
            for (int b = 0; b < 2; ++b)
#pragma unroll
                for (int m = 0; m < 4; ++m)
#pragma unroll
                    for (int n = 0; n < 2; ++n) acc[a][b][m][n] = (f32x4){0.f, 0.f, 0.f, 0.f};
        cur = nxt; cB = nB; ++ui;
    }
    PG8_WAIT_V(0);
    if (wr == 0) PG8_BAR;
    PG8_BAR;
#undef PG8_SA
#undef PG8_SB
#undef PG8_STAGE
#undef PG8_LDA
#undef PG8_LDB
#undef PG8_MMA
#undef PG8_WAIT_V
#undef PG8_WAIT_L
#undef PG8_BAR
#undef PG8_SCHED
#undef PG8_AOFF
}
}

constexpr int NTHR = 512, NWAVE = 8;
constexpr int LDS_BYTES = 147456;

__device__ __forceinline__ void transpose_item(const float* W, int K, int N, bf16_t* WT, int mode, LAS float* scr, int item, int lane) {
    const int nblk = N / 32, kb = item / nblk, nb = item % nblk, k0 = 64 * kb, n0 = 32 * nb;
#pragma unroll 8
    for (int i = 0; i < 32; ++i) { const int kk = 2 * i + (lane >> 5); scr[kk * 33 + (lane & 31)] = W[(size_t)(k0 + kk) * N + n0 + (lane & 31)]; }
    asm volatile("s_waitcnt lgkmcnt(0)" ::: "memory");
    const int c = lane & 7;
#pragma unroll
    for (int j = 0; j < 4; ++j) { const int n = (lane >> 3) + 8 * j; const LAS float* s = scr + (8 * c) * 33 + n;
        u32x4 o; o.x = pk2(s[0 * 33], s[1 * 33]); o.y = pk2(s[2 * 33], s[3 * 33]); o.z = pk2(s[4 * 33], s[5 * 33]); o.w = pk2(s[6 * 33], s[7 * 33]);
        const int ng = n0 + n; const int row = mode == 0 ? ng : (8 * (ng >> 2) + (ng & 3) + (mode == 2 ? 4 : 0));
        *(u32x4*)(WT + (size_t)row * K + k0 + 8 * c) = o; }
    asm volatile("s_waitcnt lgkmcnt(0)" ::: "memory");
}
__device__ __forceinline__ void ln_affine(f32x4 (&v)[4], const float* g, const float* b, int lane) {
    float s = 0.f;
#pragma unroll
    for (int j = 0; j < 4; ++j) s += (v[j][0] + v[j][1]) + (v[j][2] + v[j][3]);
    const float mean = wave_sum(s) * (1.f / D); float s2 = 0.f;
#pragma unroll
    for (int j = 0; j < 4; ++j) { v[j] = v[j] - mean; s2 += (v[j][0] * v[j][0] + v[j][1] * v[j][1]) + (v[j][2] * v[j][2] + v[j][3] * v[j][3]); }
    const float rstd = 1.0f / sqrtf(wave_sum(s2) * (1.f / D) + 1e-5f);
#pragma unroll
    for (int j = 0; j < 4; ++j) { const f32x4 gg = *(const f32x4*)(g + 4 * lane + 256 * j), bb = *(const f32x4*)(b + 4 * lane + 256 * j); v[j] = v[j] * rstd * gg + bb; }
}
__device__ __forceinline__ void store_row_bf16(bf16_t* row, const f32x4 (&v)[4], int lane) {
#pragma unroll
    for (int j = 0; j < 4; ++j) { u32x2 w; w.x = pk2(v[j][0], v[j][1]); w.y = pk2(v[j][2], v[j][3]); *(u32x2*)(row + 4 * lane + 256 * j) = w; }
}
__device__ __forceinline__ void ph_prologue(const Params& p, LAS unsigned char* lds) {
    const int tid = threadIdx.x, lane = tid & 63, wave = tid >> 6, gw = blockIdx.x * NWAVE + wave, NGW = gridDim.x * NWAVE;
    LAS float* scr = (LAS float*)(lds + wave * 8704);
    constexpr int N_WIN = 16 * 88, N_WOUT = 16 * 32, N_W1 = 16 * 16, N_W2 = 8 * 32, N_EXP = 2 * N_W1 + N_W2, N_LAYER = N_WIN + N_WOUT + NE * N_EXP;
    bf16_t* WIN = (bf16_t*)(p.ws + WS_WIN); bf16_t* WOUT = (bf16_t*)(p.ws + WS_WOUT); bf16_t* W13 = (bf16_t*)(p.ws + WS_W13); bf16_t* W2 = (bf16_t*)(p.ws + WS_W2);
    for (int it = gw; it < NLAYER * N_LAYER; it += NGW) {
        const int l = it / N_LAYER; int r = it % N_LAYER;
        if (r < N_WIN) { transpose_item(p.in[I_WIN] + (size_t)l * D * INW, D, INW, WIN + (size_t)l * INW * D, 0, scr, r, lane); continue; } r -= N_WIN;
        if (r < N_WOUT) { transpose_item(p.in[I_WOUT] + (size_t)l * D * D, D, D, WOUT + (size_t)l * D * D, 0, scr, r, lane); continue; } r -= N_WOUT;
        const int e = r / N_EXP, q = r % N_EXP; const size_t le = (size_t)l * NE + e;
        if (q < N_W1) transpose_item(p.in[I_EW1] + le * D * FF, D, FF, W13 + le * 1024 * 1024, 1, scr, q, lane);
        else if (q < 2 * N_W1) transpose_item(p.in[I_EW3] + le * D * FF, D, FF, W13 + le * 1024 * 1024, 2, scr, q - N_W1, lane);
        else transpose_item(p.in[I_EW2] + le * FF * D, FF, D, W2 + le * 1024 * FF, 0, scr, q - 2 * N_W1, lane);
    }
    bf16_t* HB = (bf16_t*)(p.ws + WS_HB); bf16_t* MIX = (bf16_t*)(p.ws + WS_MIX);
    for (int r = gw; r < MP; r += NGW) {
        f32x4 v[4];
        if (r >= T) {
#pragma unroll
            for (int j = 0; j < 4; ++j) v[j] = (f32x4){0.f, 0.f, 0.f, 0.f};
            store_row_bf16(MIX + (size_t)r * D, v, lane);
        } else {
            const int b = r / LT, t = r % LT;
            const float* src = t < NMETA ? p.in[I_META] + (size_t)t * D : p.in[I_X] + ((size_t)b * SEQ + (t - NMETA)) * D;
#pragma unroll
            for (int j = 0; j < 4; ++j) v[j] = *(const f32x4*)(src + 4 * lane + 256 * j);
            ln_affine(v, p.in[I_LN0G], p.in[I_LN0B], lane);
        }
        store_row_bf16(HB + (size_t)r * D, v, lane);
    }
}

__device__ __forceinline__ void ph_gemm_in(const Params& p, int l, LAS unsigned char* lds) {
    pg8::DenseOrder S; S.init(MP, INW, D, (const bf16_t*)(p.ws + WS_WIN) + (size_t)l * INW * D, gridDim.x, blockIdx.x);
    pg8::EpiBf16 E{(bf16_t*)(p.ws + WS_U), INW};
    pg8::gemm_phase(lds, (const bf16_t*)(p.ws + WS_HB), D, S, E);
}
__device__ __forceinline__ void ph_gemm_out(const Params& p, int l, LAS unsigned char* lds) {
    pg8::DenseOrder S; S.init(MP, D, D, (const bf16_t*)(p.ws + WS_WOUT) + (size_t)l * D * D, gridDim.x, blockIdx.x);
    pg8::EpiZ E{(float*)(p.ws + WS_Z), (const bf16_t*)(p.ws + WS_HB)};
    pg8::gemm_phase(lds, (const bf16_t*)(p.ws + WS_MIX), D, S, E);
}
__device__ __forceinline__ void moe_table(const Params& p, int l, LAS int* tab) {
    if (threadIdx.x == 0) {
        const unsigned* cnt = (const unsigned*)(p.ws + WS_CTL) + CW_CNT + l * 16;
        int ts = 0, ss = 0;
        for (int e = 0; e < 16; ++e) { const int c = (int)__hip_atomic_load(cnt + e, __ATOMIC_RELAXED, __HIP_MEMORY_SCOPE_AGENT); tab[e] = ts; tab[17 + e] = ss; ts += (c + 255) >> 8; ss += c; }
        tab[16] = ts; tab[33] = ss;
    }
    __syncthreads();
}
__device__ __forceinline__ void ph_gemm1(const Params& p, int l, LAS unsigned char* lds) {
    LAS int* tab = (LAS int*)(lds + pg8::STAGE_BYTES);
    moe_table(p, l, tab);
    pg8::MoeOrder S{tab, 4, (int)gridDim.x, (int)blockIdx.x, (const bf16_t*)(p.ws + WS_W13) + (size_t)l * NE * 1024 * 1024, (size_t)1024 * 1024, D, (const int*)(p.ws + WS_LIST)};
    pg8::EpiAct E{(bf16_t*)(p.ws + WS_ACT)};
    pg8::gemm_phase(lds, (const bf16_t*)(p.ws + WS_HB), D, S, E);
}
__device__ __forceinline__ void ph_gemm2(const Params& p, int l, LAS unsigned char* lds) {
    LAS int* tab = (LAS int*)(lds + pg8::STAGE_BYTES);
    moe_table(p, l, tab);
    pg8::MoeOrder S{tab, 4, (int)gridDim.x, (int)blockIdx.x, (const bf16_t*)(p.ws + WS_W2) + (size_t)l * NE * 1024 * FF, (size_t)1024 * FF, FF, nullptr};
    pg8::EpiY2 E{(bf16_t*)(p.ws + WS_Y2), (const float*)(p.ws + WS_GSL)};
    pg8::gemm_phase(lds, (const bf16_t*)(p.ws + WS_ACT), FF, S, E);
}

__device__ __forceinline__ void load8(const bf16_t* p, float* o) { const u32x4 w = *(const u32x4*)p; o[0] = bflo(w.x); o[1] = bfhi(w.x); o[2] = bflo(w.y); o[3] = bfhi(w.y); o[4] = bflo(w.z); o[5] = bfhi(w.z); o[6] = bflo(w.w); o[7] = bfhi(w.w); }
__device__ __forceinline__ void ph_swa(const Params& p, int l, LAS unsigned char* lds) {
    const int tid = threadIdx.x;
    const bf16_t* U = (const bf16_t*)(p.ws + WS_U); bf16_t* MIX = (bf16_t*)(p.ws + WS_MIX);
    LAS float* btab = (LAS float*)lds;
    for (int i = tid; i < 4 * 129; i += NTHR) { const int h = i / 129, n = i % 129; btab[i] = p.in[I_RELB][t5_bucket(n) * 8 + h]; }
    __syncthreads();
    constexpr int NQT = (LT + NTHR - 1) / NTHR;
    for (int unit = blockIdx.x; unit < NB * 4 * NQT; unit += gridDim.x) {
        const int qt = unit % NQT, bh = unit / NQT, b = bh >> 2, hq = bh & 3, hkv = hq >> 1;
        const int pq = qt * NTHR + tid;
        if (pq < LT) {
            const size_t row = (size_t)b * LT + pq;
            float q[64], o[64];
#pragma unroll
            for (int i = 0; i < 8; ++i) load8(U + row * INW + C_QA + hq * 64 + 8 * i, q + 8 * i);
#pragma unroll
            for (int i = 0; i < 64; ++i) { q[i] *= 0.125f; o[i] = 0.f; }
            float m = p.in[I_SINKS][l * 4 + hq], lsum = 1.0f;
            for (int jj = 0; jj < 144; ++jj) {
                int j; bool ok;
                if (jj < 16) { j = jj; ok = (j <= pq); } else { j = pq - 127 + (jj - 16); ok = (j >= 16); }
                if (ok) {
                    const bf16_t* kr = U + ((size_t)b * LT + j) * INW;
                    float s = 0.f;
#pragma unroll
                    for (int i = 0; i < 8; ++i) { float kv[8]; load8(kr + C_KA + hkv * 64 + 8 * i, kv);
#pragma unroll
                        for (int e = 0; e < 8; ++e) s += q[8 * i + e] * kv[e]; }
                    const int dq = pq - j; s += btab[hq * 129 + (dq < 128 ? dq : 128)];
                    const float mn = fmaxf(m, s), a = __expf(m - mn), pj = __expf(s - mn);
                    lsum = lsum * a + pj; m = mn;
#pragma unroll
                    for (int i = 0; i < 8; ++i) { float vv[8]; load8(kr + C_VA + hkv * 64 + 8 * i, vv);
#pragma unroll
                        for (int e = 0; e < 8; ++e) o[8 * i + e] = o[8 * i + e] * a + pj * vv[e]; }
                }
            }
            const float inv = 1.0f / lsum;
#pragma unroll
            for (int i = 0; i < 8; ++i) { u32x4 w; w.x = pk2(o[8 * i] * inv, o[8 * i + 1] * inv); w.y = pk2(o[8 * i + 2] * inv, o[8 * i + 3] * inv); w.z = pk2(o[8 * i + 4] * inv, o[8 * i + 5] * inv); w.w = pk2(o[8 * i + 6] * inv, o[8 * i + 7] * inv);
                *(u32x4*)(MIX + row * D + M_A + hq * 64 + 8 * i) = w; }
        }
    }
    __syncthreads();
}

__device__ __forceinline__ void ph_diff(const Params& p, int l, LAS unsigned char* lds) {
    const int tid = threadIdx.x;
    const bf16_t* U = (const bf16_t*)(p.ws + WS_U); bf16_t* MIX = (bf16_t*)(p.ws + WS_MIX);
    LAS float* btab = (LAS float*)lds;
    for (int i = tid; i < 4 * 129; i += NTHR) { const int h = i / 129, n = i % 129; btab[i] = p.in[I_RELB][t5_bucket(n) * 8 + 4 + h]; }
    __syncthreads();
    float s1 = 0.f, s2 = 0.f;
    for (int i = 0; i < 32; ++i) { s1 += p.in[I_LQ1][l * 32 + i] * p.in[I_LK1][l * 32 + i]; s2 += p.in[I_LQ2][l * 32 + i] * p.in[I_LK2][l * 32 + i]; }
    const float lam_init = 0.8f - 0.6f * expf(-0.3f * (float)l), lam = expf(s1) - expf(s2) + lam_init;
    constexpr int NQT = (LT + 255) / 256;
    for (int unit = blockIdx.x; unit < NB * 4 * NQT; unit += gridDim.x) {
        const int qt = NQT - 1 - unit / 32, bh = unit % 32, b = bh >> 2, h = bh & 3;
        const int pq = qt * 256 + (tid >> 1), c = tid & 1;
        const bool valid = pq < LT;
        const size_t row = (size_t)b * LT + (valid ? pq : 0);
        float q[32], o[64];
#pragma unroll
        for (int i = 0; i < 4; ++i) load8(U + row * INW + C_QD + h * 64 + c * 32 + 8 * i, q + 8 * i);
#pragma unroll
        for (int i = 0; i < 32; ++i) q[i] *= 0.17677669529663687f;
#pragma unroll
        for (int i = 0; i < 64; ++i) o[i] = 0.f;
        float m = -1e30f, lsum = 0.f;
        const int jend = min(qt * 256 + 255, LT - 1);
        for (int j = 0; j <= jend; ++j) {
            if (valid && j <= pq) {
                const bf16_t* kr = U + ((size_t)b * LT + j) * INW;
                float s = 0.f;
#pragma unroll
                for (int i = 0; i < 4; ++i) { float kv[8]; load8(kr + C_KD + h * 64 + c * 32 + 8 * i, kv);
#pragma unroll
                    for (int e = 0; e < 8; ++e) s += q[8 * i + e] * kv[e]; }
                const int dq = pq - j; s += btab[h * 129 + (dq < 128 ? dq : 128)];
                const float mn = fmaxf(m, s), a = __expf(m - mn), pj = __expf(s - mn);
                lsum = lsum * a + pj; m = mn;
#pragma unroll
                for (int i = 0; i < 8; ++i) { float vv[8]; load8(kr + C_VD + h * 64 + 8 * i, vv);
#pragma unroll
                    for (int e = 0; e < 8; ++e) o[8 * i + e] = o[8 * i + e] * a + pj * vv[e]; }
            }
        }
        const float sc = (c == 0 ? 1.0f : -lam) / (valid ? lsum : 1.0f);
        float ss = 0.f, res[32];
#pragma unroll
        for (int k = 0; k < 32; ++k) { float lo = o[k] * sc, hi = o[32 + k] * sc; asm volatile("" : "+v"(lo), "+v"(hi));
            const float send = c ? lo : hi, keep = c ? hi : lo; res[k] = keep + __shfl_xor(send, 1); ss += res[k] * res[k]; }
        ss += __shfl_xor(ss, 1);
        const float rn = 1.0f / sqrtf(ss * (1.f / 64.f) + 1e-5f) * (1.0f - lam_init);
        if (valid) {
#pragma unroll
            for (int i = 0; i < 4; ++i) { const int d0 = c * 32 + 8 * i; const float* g = p.in[I_SUBLN] + l * 64 + d0; u32x4 w;
                float r[8];
#pragma unroll
                for (int e = 0; e < 8; ++e) r[e] = res[8 * i + e] * rn * g[e];
                w.x = pk2(r[0], r[1]); w.y = pk2(r[2], r[3]); w.z = pk2(r[4], r[5]); w.w = pk2(r[6], r[7]);
                *(u32x4*)(MIX + row * D + M_B + h * 64 + d0) = w; }
        }
    }
    __syncthreads();
}

__device__ __forceinline__ void ph_conv(const Params& p, int l, LAS unsigned char* lds) {
    const int tid = threadIdx.x, tk = tid >> 8, c = tid & 255;
    const bf16_t* U = (const bf16_t*)(p.ws + WS_U); bf16_t* MIX = (bf16_t*)(p.ws + WS_MIX);
    const float* cw = p.in[I_CONVW] + (size_t)l * 31 * 256; const float cb = p.in[I_CONVB][l * 256 + c], gg = p.in[I_GNG][l * 256 + c], gb = p.in[I_GNB][l * 256 + c];
    float wv[31];
#pragma unroll
    for (int w = 0; w < 31; ++w) wv[w] = cw[w * 256 + c];
    for (int pr = blockIdx.x; pr < T / 2; pr += gridDim.x) {
        const int r = pr * 2 + tk, t = r % LT;
        float acc = cb;
#pragma unroll
        for (int w = 0; w < 31; ++w) { const int tt = t - 30 + w;
            if (tt >= 0) { const bf16_t* ur = U + (size_t)(r - 30 + w) * INW; const float a = bf2f(ur[C_CA + c]), g = bf2f(ur[C_CG + c]); acc += wv[w] * a * sigmoidf_(g); } }
        const float mean = wave_sum(acc) * (1.f / 64.f); const float dv = acc - mean; const float var = wave_sum(dv * dv) * (1.f / 64.f);
        const float y = dv / sqrtf(var + 1e-5f) * gg + gb;
        MIX[(size_t)r * D + M_D + c] = f2bf(y * sigmoidf_(y));
    }
}

__device__ __forceinline__ void ph_rwkv_prep(const Params& p, int l, LAS unsigned char* lds) {
    const int tid = threadIdx.x, tk = tid >> 8, c = tid & 255;
    const bf16_t* U = (const bf16_t*)(p.ws + WS_U);
    bf16_t* RB = (bf16_t*)(p.ws + WS_RWB); bf16_t* KB = RB + (size_t)T * 256; bf16_t* VB = KB + (size_t)T * 256; bf16_t* GB = VB + (size_t)T * 256;
    float* WF = p.out; float* KKF = WF + (size_t)T * 256; float* BF = KKF + (size_t)T * 256;
    LAS float* xs = (LAS float*)lds + tk * 1024; LAS float* th = (LAS float*)lds + 2048 + tk * 64; LAS float* sg = (LAS float*)lds + 2048 + 128 + tk * 128;
    const float* mu = p.in[I_MU] + l * 1024; const float* w2 = p.in[I_W2] + (size_t)l * 64 * 256; const float* a2 = p.in[I_A2] + (size_t)l * 64 * 256; const float* g2 = p.in[I_G2] + (size_t)l * 128 * 256;
    const float w0 = p.in[I_W0][l * 256 + c], a0 = p.in[I_A0][l * 256 + c], kkp = p.in[I_KK][l * 256 + c], kap = p.in[I_KA][l * 256 + c];
    for (int pr = blockIdx.x; pr < T / 2; pr += gridDim.x) {
        const int r = pr * 2 + tk, t = r % LT;
        __syncthreads();
#pragma unroll
        for (int q = 0; q < 4; ++q) { const int col = q * 256 + c; const float cur = bf2f(U[(size_t)r * INW + C_RW + col]); const float prv = t > 0 ? bf2f(U[(size_t)(r - 1) * INW + C_RW + col]) : 0.f;
            xs[col] = cur + mu[col] * (prv - cur); }
        __syncthreads();
        if (c < 64) th[c] = tanhf(xs[768 + c]); else if (c < 192) sg[c - 64] = sigmoidf_(xs[896 + (c - 64)]);
        __syncthreads();
        float aw = w0, aa = a0, ag = 0.f;
#pragma unroll 4
        for (int i = 0; i < 64; ++i) { aw += th[i] * w2[i * 256 + c]; aa += xs[832 + i] * a2[i * 256 + c]; }
#pragma unroll 4
        for (int i = 0; i < 128; ++i) ag += sg[i] * g2[i * 256 + c];
        const float w = __expf(-0.6065306597126334f * sigmoidf_(aw)), a = sigmoidf_(aa);
        const float rr = xs[c], k = xs[256 + c], v = xs[512 + c];
        const float kkr = k * kkp; const float n2 = wave_sum(kkr * kkr); const float kk = kkr / fmaxf(sqrtf(n2), 1e-12f);
        const float km = k * (1.0f + (a - 1.0f) * kap);
        const size_t o = (size_t)r * 256 + c;
        RB[o] = f2bf(rr); KB[o] = f2bf(km); VB[o] = f2bf(v); GB[o] = f2bf(ag); WF[o] = w; KKF[o] = kk; BF[o] = kk * a;
    }
    __syncthreads();
}
__device__ __forceinline__ void ph_rwkv_scan(const Params& p, int l, LAS unsigned char* lds) {
    const int tid = threadIdx.x, lane = tid & 63, wave = tid >> 6, irow = wave * 8 + (lane >> 3), jg = lane & 7;
    const bf16_t* RB = (const bf16_t*)(p.ws + WS_RWB); const bf16_t* KB = RB + (size_t)T * 256; const bf16_t* VB = KB + (size_t)T * 256; const bf16_t* GB = VB + (size_t)T * 256;
    const float* WF = p.out; const float* KKF = WF + (size_t)T * 256; const float* BF = KKF + (size_t)T * 256;
    bf16_t* MIX = (bf16_t*)(p.ws + WS_MIX);
    constexpr int CH = 32;
    LAS float* Lw = (LAS float*)lds; LAS float* Lkk = Lw + CH * 64; LAS float* Lb = Lkk + CH * 64; LAS float* Lk = Lb + CH * 64; LAS float* Lr = Lk + CH * 64;
    LAS float* Lv = Lr + CH * 64; LAS float* Lg = Lv + CH * 64; LAS float* Ly = Lg + CH * 64;
    for (int bh = blockIdx.x; bh < NB * 4; bh += gridDim.x) {
        const int b = bh >> 2, h = bh & 3;
        float S[8];
#pragma unroll
        for (int e = 0; e < 8; ++e) S[e] = 0.f;
        const float rk = p.in[I_RK][l * 256 + h * 64 + lane], lg = p.in[I_LNXG][l * 256 + h * 64 + lane], lb = p.in[I_LNXB][l * 256 + h * 64 + lane];
        for (int t0 = 0; t0 < LT; t0 += CH) {
            const int nt = min(CH, LT - t0);
            __syncthreads();
            for (int i = tid; i < CH * 64; i += NTHR) { const int tt = i >> 6, j = i & 63;
                if (tt < nt) { const size_t o = ((size_t)b * LT + t0 + tt) * 256 + h * 64 + j;
                    Lw[i] = WF[o]; Lkk[i] = KKF[o]; Lb[i] = BF[o]; Lk[i] = bf2f(KB[o]); Lr[i] = bf2f(RB[o]); Lv[i] = bf2f(VB[o]); Lg[i] = bf2f(GB[o]); } }
            __syncthreads();
            for (int tt = 0; tt < nt; ++tt) {
                const LAS float* q = (const LAS float*)lds + tt * 64 + jg * 8;
                const f32x4 k0 = *(const LAS f32x4*)(q + CH * 64), k1 = *(const LAS f32x4*)(q + CH * 64 + 4);
                float sa = S[0] * k0[0] + S[1] * k0[1] + S[2] * k0[2] + S[3] * k0[3] + S[4] * k1[0] + S[5] * k1[1] + S[6] * k1[2] + S[7] * k1[3];
                sa += __shfl_xor(sa, 1); sa += __shfl_xor(sa, 2); sa += __shfl_xor(sa, 4); sa = -sa;
                const f32x4 w0 = *(const LAS f32x4*)(q), w1 = *(const LAS f32x4*)(q + 4), b0 = *(const LAS f32x4*)(q + 2 * CH * 64), b1 = *(const LAS f32x4*)(q + 2 * CH * 64 + 4);
                const f32x4 m0 = *(const LAS f32x4*)(q + 3 * CH * 64), m1 = *(const LAS f32x4*)(q + 3 * CH * 64 + 4), r0 = *(const LAS f32x4*)(q + 4 * CH * 64), r1 = *(const LAS f32x4*)(q + 4 * CH * 64 + 4);
                const float v = Lv[tt * 64 + irow];
                float y = 0.f;
#pragma unroll
                for (int e = 0; e < 4; ++e) { S[e] = S[e] * w0[e] + sa * b0[e] + v * m0[e]; y += S[e] * r0[e]; S[4 + e] = S[4 + e] * w1[e] + sa * b1[e] + v * m1[e]; y += S[4 + e] * r1[e]; }
                y += __shfl_xor(y, 1); y += __shfl_xor(y, 2); y += __shfl_xor(y, 4);
                if (jg == 0) Ly[tt * 64 + irow] = y;
            }
            __syncthreads();
            for (int tt = wave; tt < nt; tt += NWAVE) {
                const int i = tt * 64 + lane;
                const float y = Ly[i]; const float mean = wave_sum(y) * (1.f / 64.f); const float dv = y - mean; const float var = wave_sum(dv * dv) * (1.f / 64.f);
                const float yn = dv / sqrtf(var + 64e-5f) * lg + lb;
                const float bonus = wave_sum(Lr[i] * Lk[i] * rk) * Lv[i];
                MIX[((size_t)b * LT + t0 + tt) * D + M_C + h * 64 + lane] = f2bf((yn + bonus) * Lg[i]);
            }
        }
    }
    __syncthreads();
}

__device__ __forceinline__ void ph_ln1(const Params& p, int l, LAS unsigned char* lds) {
    const int tid = threadIdx.x, lane = tid & 63, wave = tid >> 6, gw = blockIdx.x * NWAVE + wave, NGW = gridDim.x * NWAVE;
    LAS float* rw = (LAS float*)lds;
    for (int i = tid; i < D * NE / 4; i += NTHR) *(LAS f32x4*)(rw + 4 * i) = *(const f32x4*)(p.in[I_ROUTW] + 4 * i);
    __syncthreads();
    const float* Z = (const float*)(p.ws + WS_Z); bf16_t* HB = (bf16_t*)(p.ws + WS_HB);
    unsigned* cnt = (unsigned*)(p.ws + WS_CTL) + CW_CNT + l * 16;
    int* TE = (int*)(p.ws + WS_TOKE); int* TP = (int*)(p.ws + WS_TOKP); float* TG = (float*)(p.ws + WS_TOKG);
    for (int r = gw; r < T; r += NGW) {
        f32x4 v[4];
#pragma unroll
        for (int j = 0; j < 4; ++j) v[j] = *(const f32x4*)(Z + (size_t)r * D + 4 * lane + 256 * j);
        ln_affine(v, p.in[I_LN1G] + l * D, p.in[I_LN1B] + l * D, lane);
        store_row_bf16(HB + (size_t)r * D, v, lane);
        float lg[16];
#pragma unroll
        for (int e = 0; e < 16; ++e) lg[e] = 0.f;
#pragma unroll
        for (int j = 0; j < 4; ++j)
#pragma unroll 1
            for (int i = 0; i < 4; ++i) { const LAS float* wr_ = rw + (4 * lane + 256 * j + i) * 16; const float x = (i == 0 ? v[j][0] : i == 1 ? v[j][1] : i == 2 ? v[j][2] : v[j][3]);
#pragma unroll
                for (int q = 0; q < 4; ++q) { const f32x4 w = *(const LAS f32x4*)(wr_ + 4 * q); lg[4 * q] += x * w[0]; lg[4 * q + 1] += x * w[1]; lg[4 * q + 2] += x * w[2]; lg[4 * q + 3] += x * w[3]; } }
        float sc[16], bi[16];
#pragma unroll
        for (int e = 0; e < 16; ++e) { const float s = wave_sum(lg[e]); sc[e] = 1.0f / (1.0f + expf(-s)); bi[e] = sc[e] + p.in[I_ROUTB][e]; }
        int bg = 0; float bgs = -1e30f;
#pragma unroll
        for (int g = 0; g < 4; ++g) { float m1 = -1e30f, m2 = -1e30f;
#pragma unroll
            for (int i = 0; i < 4; ++i) { const float x = bi[4 * g + i]; if (x > m1) { m2 = m1; m1 = x; } else if (x > m2) m2 = x; }
            const float s = m1 + m2; if (s > bgs) { bgs = s; bg = g; } }
        int i1 = 0, i2 = 0; float m1 = -1e30f, m2 = -1e30f, s1 = 0.f, s2 = 0.f;
#pragma unroll
        for (int g = 0; g < 4; ++g) if (g == bg) {
#pragma unroll
            for (int i = 0; i < 4; ++i) { const float x = bi[4 * g + i]; if (x > m1) { m1 = x; i1 = 4 * g + i; s1 = sc[4 * g + i]; } }
#pragma unroll
            for (int i = 0; i < 4; ++i) { const float x = bi[4 * g + i]; if (4 * g + i != i1 && x > m2) { m2 = x; i2 = 4 * g + i; s2 = sc[4 * g + i]; } }
        }
        if (lane == 0) {
            const int p1 = (int)atomicAdd(cnt + i1, 1u), p2 = (int)atomicAdd(cnt + i2, 1u);
            TE[2 * r] = i1; TE[2 * r + 1] = i2; TP[2 * r] = p1; TP[2 * r + 1] = p2; const float inv = 1.0f / (s1 + s2); TG[2 * r] = s1 * inv; TG[2 * r + 1] = s2 * inv;
        }
    }
    __syncthreads();
}
__device__ __forceinline__ void ph_scatter(const Params& p, int l, LAS unsigned char* lds) {
    LAS int* tab = (LAS int*)lds;
    moe_table(p, l, tab);
    const int* TE = (const int*)(p.ws + WS_TOKE); const int* TP = (const int*)(p.ws + WS_TOKP); const float* TG = (const float*)(p.ws + WS_TOKG);
    int* TS = (int*)(p.ws + WS_TOKS); int* LIST = (int*)(p.ws + WS_LIST); float* GSL = (float*)(p.ws + WS_GSL);
    for (int i = blockIdx.x * NTHR + threadIdx.x; i < NSLOTP; i += gridDim.x * NTHR) {
        if (i < NSLOT) { const int e = TE[i], slot = tab[17 + e] + TP[i]; TS[i] = slot; LIST[slot] = i >> 1; GSL[slot] = TG[i]; }
        else { LIST[i] = 0; GSL[i] = 0.f; }
    }
    __syncthreads();
}
__device__ __forceinline__ void ph_ln2(const Params& p, int l, LAS unsigned char* lds) {
    const int tid = threadIdx.x, lane = tid & 63, wave = tid >> 6, gw = blockIdx.x * NWAVE + wave, NGW = gridDim.x * NWAVE;
    bf16_t* HB = (bf16_t*)(p.ws + WS_HB); const bf16_t* Y2 = (const bf16_t*)(p.ws + WS_Y2); const int* TS = (const int*)(p.ws + WS_TOKS);
    for (int r = gw; r < T; r += NGW) {
        const int b = r / LT, t = r % LT;
        if (l == NLAYER - 1 && t < NMETA) continue;
        const int s0 = TS[2 * r], s1 = TS[2 * r + 1];
        f32x4 v[4];
#pragma unroll
        for (int j = 0; j < 4; ++j) { const u32x2 h = *(const u32x2*)(HB + (size_t)r * D + 4 * lane + 256 * j), a = *(const u32x2*)(Y2 + (size_t)s0 * D + 4 * lane + 256 * j), c = *(const u32x2*)(Y2 + (size_t)s1 * D + 4 * lane + 256 * j);
            v[j][0] = ALPHA * bflo(h.x) + bflo(a.x) + bflo(c.x); v[j][1] = ALPHA * bfhi(h.x) + bfhi(a.x) + bfhi(c.x); v[j][2] = ALPHA * bflo(h.y) + bflo(a.y) + bflo(c.y); v[j][3] = ALPHA * bfhi(h.y) + bfhi(a.y) + bfhi(c.y); }
        ln_affine(v, p.in[I_LN2G] + l * D, p.in[I_LN2B] + l * D, lane);
        if (l == NLAYER - 1) { float* o = p.out + ((size_t)b * SEQ + (t - NMETA)) * D;
#pragma unroll
            for (int j = 0; j < 4; ++j) *(f32x4*)(o + 4 * lane + 256 * j) = v[j]; }
        else store_row_bf16(HB + (size_t)r * D, v, lane);
    }
}

enum { PH_PROLOGUE = 0, PH_GEMM_IN, PH_SWA, PH_DIFF, PH_CONV, PH_PREP, PH_SCAN, PH_GEMM_OUT, PH_LN1, PH_SCATTER, PH_GEMM1, PH_GEMM2, PH_LN2 };
template <int PH> __global__ void __launch_bounds__(NTHR, 2) k_phase(Params p, int l) {
    extern __shared__ __attribute__((aligned(16))) unsigned char smem[];
    LAS unsigned char* lds = (LAS unsigned char*)smem;
    if (PH == PH_PROLOGUE) ph_prologue(p, lds);
    if (PH == PH_GEMM_IN) ph_gemm_in(p, l, lds);
    if (PH == PH_SWA) ph_swa(p, l, lds);
    if (PH == PH_DIFF) ph_diff(p, l, lds);
    if (PH == PH_CONV) ph_conv(p, l, lds);
    if (PH == PH_PREP) ph_rwkv_prep(p, l, lds);
    if (PH == PH_SCAN) ph_rwkv_scan(p, l, lds);
    if (PH == PH_GEMM_OUT) ph_gemm_out(p, l, lds);
    if (PH == PH_LN1) ph_ln1(p, l, lds);
    if (PH == PH_SCATTER) ph_scatter(p, l, lds);
    if (PH == PH_GEMM1) ph_gemm1(p, l, lds);
    if (PH == PH_GEMM2) ph_gemm2(p, l, lds);
    if (PH == PH_LN2) ph_ln2(p, l, lds);
}

template <int PH> static void launch_phase(const Params& p, int l, int grid, hipStream_t stream) {
    static bool attr = false;
    if (!attr) { (void)hipFuncSetAttribute((const void*)k_phase<PH>, hipFuncAttributeMaxDynamicSharedMemorySize, LDS_BYTES); attr = true; }
    hipLaunchKernelGGL(k_phase<PH>, dim3(grid), dim3(NTHR), LDS_BYTES, stream, p, l);
}

extern "C" void kernel_launch(void* const* d_in, const int* in_sizes, int n_in, void* d_out, int out_size, void* d_ws, size_t ws_size, hipStream_t stream) {
    if (n_in != 37 || ws_size < WS_END) { fprintf(stderr, "kernel_launch: unexpected arguments (n_in %d, ws %zu, need %zu)\n", n_in, ws_size, (size_t)WS_END); return; }
    Params p{};
    for (int i = 0; i < 37; ++i) p.in[i] = (const float*)d_in[i];
    p.out = (float*)d_out; p.ws = (unsigned char*)d_ws;
    (void)hipMemsetAsync((char*)d_ws + WS_CTL, 0, CTL_BYTES, stream);
    const int grid = 256;
    launch_phase<PH_PROLOGUE>(p, 0, grid, stream);
    for (int l = 0; l < NLAYER; ++l) {
        launch_phase<PH_GEMM_IN>(p, l, grid, stream);
        launch_phase<PH_SWA>(p, l, grid, stream);
        launch_phase<PH_DIFF>(p, l, grid, stream);
        launch_phase<PH_CONV>(p, l, grid, stream);
        launch_phase<PH_PREP>(p, l, grid, stream);
        launch_phase<PH_SCAN>(p, l, grid, stream);
        launch_phase<PH_GEMM_OUT>(p, l, grid, stream);
        launch_phase<PH_LN1>(p, l, grid, stream);
        launch_phase<PH_SCATTER>(p, l, grid, stream);
        launch_phase<PH_GEMM1>(p, l, grid, stream);
        launch_phase<PH_GEMM2>(p, l, grid, stream);
        launch_phase<PH_LN2>(p, l, grid, stream);
    }
}
```

```cpp
#include <hip/hip_runtime.h>
#include <stdint.h>
#include <stdio.h>

#ifndef PROBE_DUP
#define PROBE_DUP 0
#endif
#ifndef MK_ONE_LAUNCH
#define MK_ONE_LAUNCH 1
#endif

#define LAS __attribute__((address_space(3)))
typedef unsigned short bf16_t;
typedef short bf16x8 __attribute__((ext_vector_type(8)));
typedef float f32x4 __attribute__((ext_vector_type(4)));
typedef float f32x2 __attribute__((ext_vector_type(2)));
typedef unsigned u32x4 __attribute__((ext_vector_type(4)));
typedef unsigned u32x2 __attribute__((ext_vector_type(2)));

constexpr int D = 1024, NB = 8, SEQ = 4096, NMETA = 16, LT = SEQ + NMETA, T = NB * LT  , MP = 33024  ;
constexpr int INW = 2816, NLAYER = 2, NE = 16, FF = 512;
constexpr int NSLOT = 2 * T  , NSLOTP = NSLOT + 256;
constexpr float ALPHA = 1.41421356237f;
constexpr int C_QA = 0, C_KA = 256, C_VA = 384, C_QD = 512, C_KD = 768, C_VD = 1024, C_RW = 1280, C_CA = 2304, C_CG = 2560;
constexpr int M_A = 0, M_B = 256, M_C = 512, M_D = 768;

constexpr size_t AL(size_t x) { return (x + 255) & ~(size_t)255; }
constexpr size_t WS_CTL = 0, CTL_BYTES = 65536;
constexpr size_t WS_HB = WS_CTL + CTL_BYTES;
constexpr size_t WS_U = WS_HB + (size_t)MP * D * 2;
constexpr size_t WS_MIX = WS_U + (size_t)MP * INW * 2;
constexpr size_t WS_WIN = WS_MIX + (size_t)MP * D * 2;
constexpr size_t WS_WOUT = WS_WIN + (size_t)NLAYER * INW * D * 2;
constexpr size_t WS_W13 = WS_WOUT + (size_t)NLAYER * D * D * 2;
constexpr size_t WS_W2 = WS_W13 + (size_t)NLAYER * NE * 1024 * 1024 * 2;
constexpr size_t WS_TOKE = WS_W2 + (size_t)NLAYER * NE * 1024 * FF * 2;
constexpr size_t WS_TOKP = WS_TOKE + AL((size_t)T * 8);
constexpr size_t WS_TOKG = WS_TOKP + AL((size_t)T * 8);
constexpr size_t WS_LIST = WS_TOKG + AL((size_t)T * 8);
constexpr size_t WS_GSL = WS_LIST + AL((size_t)NE * T * 4);
constexpr size_t WS_RWB = WS_GSL + AL((size_t)NE * T * 4);
constexpr int LTP = 4160;
constexpr size_t WS_VTD = WS_RWB + (size_t)4 * T * 256 * 2;
constexpr size_t WS_VTA = WS_VTD + (size_t)NB * 4 * 64 * LTP * 2;
constexpr size_t WS_LORA = WS_VTA + (size_t)NB * 2 * 64 * LTP * 2;
constexpr size_t WS_END = WS_LORA + (size_t)NLAYER * 65536 * 2;
constexpr int RCH = 65, RUN = NB * 4 * RCH;
constexpr size_t RMB = (size_t)RUN * 64 * 64 * 2;
constexpr size_t RO_AT = 0, RO_BT = RMB, RO_KT = 2 * RMB, RO_RT = 3 * RMB, RO_VV = 4 * RMB, RO_PT = 5 * RMB, RO_QT = 6 * RMB, RO_SH = 0;
static_assert(7 * RMB <= (size_t)NB * SEQ * D * 4, "rwkv matrices in d_out");
constexpr size_t RW_GT = 0, RW_YL = RMB, RW_G = 2 * RMB, RW_BC = RW_G + (size_t)T * 256 * 2, RW_GC = RW_BC + (size_t)T * 4 * 4, RW_END = RW_GC + (size_t)RUN * 64 * 4;
static_assert(RW_END <= (size_t)4 * T * 256 * 2, "rwkv buffers in RWB");
constexpr size_t WS_Z = WS_U;
constexpr size_t WS_ZP = WS_U + (size_t)80 * 1024 * 1024;
constexpr int ZSPLIT = 4;
constexpr size_t WS_ACT = WS_U;
constexpr size_t WS_Y2 = WS_ACT + (size_t)NSLOTP * FF * 2;
static_assert(WS_Y2 + (size_t)NSLOTP * D * 2 <= WS_WIN, "moe alias");
static_assert(WS_END <= (size_t)536870912, "workspace");
constexpr int CW_BAR = 0;
constexpr int CW_CNT = 4096;
constexpr int CW_DQ = 4160;
constexpr int CW_R2D = 6144;
constexpr int CW_KMX = 5120;
static_assert((size_t)3 * T * 256 * 4 <= (size_t)NB * SEQ * D * 4, "rwkv f32 temporaries");

struct Params { const float* in[37]; float* out; unsigned char* ws; };
enum { I_X = 0, I_META, I_LN0G, I_LN0B, I_WIN, I_SINKS, I_RELB, I_LQ1, I_LK1, I_LQ2, I_LK2, I_SUBLN, I_MU, I_W0, I_W2, I_A0, I_A2, I_G2, I_KK, I_KA, I_RK,
       I_LNXG, I_LNXB, I_CONVW, I_CONVB, I_GNG, I_GNB, I_WOUT, I_LN1G, I_LN1B, I_ROUTW, I_ROUTB, I_EW1, I_EW3, I_EW2, I_LN2G, I_LN2B };

__device__ __forceinline__ float bf2f(bf16_t b) { return __uint_as_float(((unsigned)b) << 16); }
__device__ __forceinline__ bf16_t f2bf(float f) { unsigned u = __float_as_uint(f); u += 0x7FFFu + ((u >> 16) & 1u); return (bf16_t)(u >> 16); }
__device__ __forceinline__ unsigned pk2(float lo, float hi) { return (unsigned)f2bf(lo) | ((unsigned)f2bf(hi) << 16); }
__device__ __forceinline__ float bflo(unsigned w) { return __uint_as_float(w << 16); }
__device__ __forceinline__ float bfhi(unsigned w) { return __uint_as_float(w & 0xFFFF0000u); }
template <int CTRL, int ROWMASK> __device__ __forceinline__ float dpp_add(float v) {
    return v + __int_as_float(__builtin_amdgcn_update_dpp(0, __float_as_int(v), CTRL, ROWMASK, 0xF, false));
}
template <int CTRL> __device__ __forceinline__ float dpp_get(float v) { return __int_as_float(__builtin_amdgcn_update_dpp(0, __float_as_int(v), CTRL, 0xF, 0xF, false)); }
__device__ __forceinline__ float row_sum16(float v) {
    v = dpp_add<0xB1, 0xF>(v); v = dpp_add<0x4E, 0xF>(v); v = dpp_add<0x141, 0xF>(v); v = dpp_add<0x140, 0xF>(v); return v;
}
__device__ __forceinline__ float wave_sum(float v) {
    v = row_sum16(v); v = dpp_add<0x142, 0xA>(v); v = dpp_add<0x143, 0xC>(v);
    return __int_as_float(__builtin_amdgcn_readlane(__float_as_int(v), 63));
}
__device__ __forceinline__ float half_sum32(float v) {
    v = row_sum16(v); v = dpp_add<0x142, 0xA>(v);
    const float lo = __int_as_float(__builtin_amdgcn_readlane(__float_as_int(v), 31)), hi = __int_as_float(__builtin_amdgcn_readlane(__float_as_int(v), 63));
    return (__builtin_amdgcn_mbcnt_hi(~0u, __builtin_amdgcn_mbcnt_lo(~0u, 0u)) < 32u) ? lo : hi;
}
__device__ __forceinline__ float frcp(float x) { return __builtin_amdgcn_rcpf(x); }
__device__ __forceinline__ float frsq(float x) { return __builtin_amdgcn_rsqf(x); }
__device__ __forceinline__ float sigmoidf_(float x) { return frcp(1.0f + __expf(-x)); }
__device__ __forceinline__ int t5_bucket(int n) {
    if (n < 16) return n;
    int b = 16;
    b += (n >= 19); b += (n >= 21); b += (n >= 24); b += (n >= 27); b += (n >= 31); b += (n >= 35); b += (n >= 40); b += (n >= 46);
    b += (n >= 52); b += (n >= 59); b += (n >= 67); b += (n >= 77); b += (n >= 87); b += (n >= 99); b += (n >= 113);
    return b;
}


__device__ __forceinline__ int lt_tid(int wv) { int ln; asm volatile("v_mbcnt_lo_u32_b32 %0, -1, 0\n\tv_mbcnt_hi_u32_b32 %0, -1, %0" : "=v"(ln)); return (wv << 6) | ln; }
__device__ __forceinline__ int lt_bid() { int b = blockIdx.x; asm volatile("" : "+s"(b)); return b; }
#define GAS __attribute__((address_space(1)))
__device__ __forceinline__ unsigned char* lt_ptr(unsigned char* q) { unsigned long long a = (unsigned long long)q; asm volatile("" : "+s"(a)); return (unsigned char*)(GAS unsigned char*)a; }
template <class Tp> __device__ __forceinline__ const Tp* gptr(const Tp* q) { return (const Tp*)(const GAS Tp*)(unsigned long long)q; }

namespace pg8 {
constexpr int BM = 256, BK = 64, HALF = 128, HTB = HALF * BK * 2, STAGE_BYTES = 8 * HTB, NXCD = 8, WGM = 8;
__host__ __device__ __forceinline__ int lds_byte(int r, int c) { const int st = (r >> 4) * 2 + (c >> 5), rr = r & 15, cc = c & 31, ob = rr * 64 + cc * 2; return st * 1024 + (ob ^ (((ob >> 9) & 1) << 5)); }
__host__ __device__ __forceinline__ void stage_rc(int b, int& R, int& C) { const int st = b / 1024, sb = b % 1024, swz = sb ^ (((sb >> 9) & 1) << 5); R = (st >> 1) * 16 + swz / 64; C = (st & 1) * 32 + (swz % 64) / 2; }
__host__ __device__ __forceinline__ int perm32(int rho) { const int n = rho >> 4, i = rho & 15; return 8 * (i >> 2) + 4 * n + (i & 3); }

struct Unit { int pn, row0, rend, e, koff, kt, loff; };

struct DenseOrder {
    int nM, nN, nwg, G, c, M; const bf16_t* Bt; int K, ksplit;
    __device__ void init(int M_, int N, int K_, const bf16_t* Bt_, int G_, int c_, int ksplit_ = 1) { M = M_; ksplit = ksplit_; nM = M_ / BM - (ksplit_ > 1 ? 1 : 0); nN = N / BM; nwg = nM * nN; G = G_; c = c_; Bt = Bt_; K = K_; }
    __device__ bool next(int i, Unit& u) const {
        const long L = (long)i * G + c;
        const int x = (int)(L - nwg); const bool tail = L >= nwg;
        if (tail && (ksplit <= 1 || x >= nN * ksplit)) return false;
        int wgid = tail ? 0 : (int)L; { const int q = nwg / NXCD, r = nwg % NXCD, xcd = wgid % NXCD, off = wgid / NXCD; wgid = (xcd < r ? xcd * (q + 1) : r * (q + 1) + (xcd - r) * q) + off; }
        const int nig = WGM * nN, gid = wgid / nig, fm = gid * WGM, gsz = (nM - fm) < WGM ? (nM - fm) : WGM;
        const int ks = tail ? x / nN : 0;
        u.row0 = tail ? nM * BM : (fm + ((wgid % nig) % gsz)) * BM; u.pn = tail ? x % nN : (wgid % nig) / gsz; u.rend = M; u.e = ks;
        u.koff = tail ? ks * (K / ksplit) : 0; u.kt = tail ? K / ksplit / BK : K / BK; u.loff = 0; return true;
    }
    __device__ __forceinline__ const char* b_ptr(const Unit& u) const { return (const char*)Bt + ((size_t)u.pn * BM * K + u.koff) * 2; }
    __device__ __forceinline__ unsigned a_row(const Unit& u, int r) const { return (unsigned)(u.row0 + r); }
};
struct MoeOrder {
    const LAS int* tab; int nN, G, c; const bf16_t* Bt; size_t bstride; int K; const int* list;
    __device__ bool next(int i, Unit& u) const {
        const long L0 = (long)i * G + c; const int ntile = tab[16], nwg = ntile * nN;
        if (L0 >= (long)nwg) return false;
        int L = (int)L0; { const int q = nwg / NXCD, r = nwg % NXCD, xcd = L % NXCD, off = L / NXCD; L = (xcd < r ? xcd * (q + 1) : r * (q + 1) + (xcd - r) * q) + off; }
        const int tile = L / nN; u.pn = L % nN;
        int e = 0;
#pragma unroll
        for (int k = 1; k < 16; ++k) e += (tab[k] <= tile) ? 1 : 0;
        u.e = e; u.row0 = tab[17 + e] + (tile - tab[e]) * BM; u.rend = tab[17 + e + 1]; u.koff = 0; u.kt = K / BK; u.loff = e * T - tab[17 + e]; return true;
    }
    __device__ __forceinline__ const char* b_ptr(const Unit& u) const { return (const char*)Bt + ((size_t)u.e * bstride + (size_t)u.pn * BM * K) * 2; }
    __device__ __forceinline__ unsigned a_row(const Unit& u, int r) const { return list ? (unsigned)list[u.loff + min(u.row0 + r, u.rend - 1)] : (unsigned)(u.row0 + r); }
};

typedef float f32x2c __attribute__((ext_vector_type(2))); typedef __bf16 bf16x2c __attribute__((ext_vector_type(2)));
__device__ __forceinline__ unsigned cvt_pk_bf16(float lo, float hi) { f32x2c v = {lo, hi}; bf16x2c b = __builtin_convertvector(v, bf16x2c); return __builtin_bit_cast(unsigned, b); }

struct EpiBf16 {
    static constexpr bool PERM = true;
    bf16_t* O; int ldc;
    __device__ __forceinline__ void operator()(const f32x4 (&acc)[2][2][4][2], const Unit& u, int wr, int wc, int fr, int fq) const {
        const int row0 = u.row0 + wr * 64 + fr, col0 = u.pn * BM + wc * 32 + 8 * fq;
#pragma unroll
        for (int ai = 0; ai < 2; ++ai)
#pragma unroll
            for (int m = 0; m < 4; ++m) { bf16_t* rowp = O + (size_t)(row0 + ai * HALF + m * 16) * ldc + col0;
#pragma unroll
                for (int bj = 0; bj < 2; ++bj) { const f32x4 v0 = acc[ai][bj][m][0], v1 = acc[ai][bj][m][1];
                    u32x4 w; w.x = cvt_pk_bf16(v0[0], v0[1]); w.y = cvt_pk_bf16(v0[2], v0[3]); w.z = cvt_pk_bf16(v1[0], v1[1]); w.w = cvt_pk_bf16(v1[2], v1[3]);
                    *(u32x4*)(rowp + bj * HALF) = w; } }
    }
};
struct EpiU {
    static constexpr bool PERM = true;
    bf16_t* O; bf16_t* VTD; bf16_t* VTA;
    __device__ __forceinline__ void operator()(const f32x4 (&acc)[2][2][4][2], const Unit& u, int wr, int wc, int fr, int fq) const {
        const int row0 = u.row0 + wr * 64 + fr, col0 = u.pn * BM + wc * 32 + 8 * fq;
#pragma unroll
        for (int ai = 0; ai < 2; ++ai)
#pragma unroll
            for (int m = 0; m < 4; ++m) { const int row = row0 + ai * HALF + m * 16; bf16_t* rowp = O + (size_t)row * INW + col0;
                const int b = row / LT, t = row - b * LT; const int tp = (t & ~12) | ((t & 4) << 1) | ((t & 8) >> 1);
#pragma unroll
                for (int bj = 0; bj < 2; ++bj) { const f32x4 v0 = acc[ai][bj][m][0], v1 = acc[ai][bj][m][1];
                    u32x4 w; w.x = cvt_pk_bf16(v0[0], v0[1]); w.y = cvt_pk_bf16(v0[2], v0[3]); w.z = cvt_pk_bf16(v1[0], v1[1]); w.w = cvt_pk_bf16(v1[2], v1[3]);
                    *(u32x4*)(rowp + bj * HALF) = w;
                    const int c = col0 + bj * HALF;
                    if (row < T && (u.pn == 4 || (u.pn == 1 && bj == 1))) {
                        bf16_t* vt = u.pn == 4 ? VTD + ((size_t)(b * 4 + ((c - C_VD) >> 6)) * 64 + ((c - C_VD) & 63)) * LTP + tp
                                               : VTA + ((size_t)(b * 2 + ((c - C_VA) >> 6)) * 64 + ((c - C_VA) & 63)) * LTP + tp;
                        const unsigned ww[4] = {w.x, w.y, w.z, w.w};
#pragma unroll
                        for (int e = 0; e < 4; ++e) { vt[(size_t)(2 * e) * LTP] = (bf16_t)ww[e]; vt[(size_t)(2 * e + 1) * LTP] = (bf16_t)(ww[e] >> 16); } } } }
    }
};
struct EpiZ {
    static constexpr bool PERM = true;
    bf16_t* Z; const bf16_t* hb; float* ZP; int Kfull;
    __device__ __forceinline__ void operator()(const f32x4 (&acc)[2][2][4][2], const Unit& u, int wr, int wc, int fr, int fq) const {
        const int row0 = u.row0 + wr * 64 + fr, col0 = u.pn * BM + wc * 32 + 8 * fq;
        if (u.kt * BK < Kfull) {
            float* zp = ZP + ((size_t)u.e * BM + (wr * 64 + fr)) * D + col0;
#pragma unroll
            for (int ai = 0; ai < 2; ++ai)
#pragma unroll
                for (int m = 0; m < 4; ++m)
#pragma unroll
                    for (int bj = 0; bj < 2; ++bj) { float* q = zp + (size_t)(ai * HALF + m * 16) * D + bj * HALF; *(f32x4*)q = acc[ai][bj][m][0]; *(f32x4*)(q + 4) = acc[ai][bj][m][1]; }
            return;
        }
#pragma unroll
        for (int ai = 0; ai < 2; ++ai)
#pragma unroll
            for (int m = 0; m < 4; ++m) { const size_t ro = (size_t)(row0 + ai * HALF + m * 16) * D + col0;
#pragma unroll
                for (int bj = 0; bj < 2; ++bj) { const u32x4 h = *(const u32x4*)(hb + ro + bj * HALF); const f32x4 v0 = acc[ai][bj][m][0], v1 = acc[ai][bj][m][1];
                    u32x4 w; w.x = cvt_pk_bf16(v0[0] + ALPHA * bflo(h.x), v0[1] + ALPHA * bfhi(h.x)); w.y = cvt_pk_bf16(v0[2] + ALPHA * bflo(h.y), v0[3] + ALPHA * bfhi(h.y));
                    w.z = cvt_pk_bf16(v1[0] + ALPHA * bflo(h.z), v1[1] + ALPHA * bfhi(h.z)); w.w = cvt_pk_bf16(v1[2] + ALPHA * bflo(h.w), v1[3] + ALPHA * bfhi(h.w));
                    *(u32x4*)(Z + ro + bj * HALF) = w; } }
    }
};
struct EpiAct {
    static constexpr bool PERM = true;
    bf16_t* A;
    __device__ __forceinline__ void operator()(const f32x4 (&acc)[2][2][4][2], const Unit& u, int wr, int wc, int fr, int fq) const {
        const int row0 = u.row0 + wr * 64 + fr, col0 = (u.pn * BM + wc * 32 + 8 * fq) >> 1;
#pragma unroll
        for (int ai = 0; ai < 2; ++ai)
#pragma unroll
            for (int m = 0; m < 4; ++m) { const int row = row0 + ai * HALF + m * 16; if (row < u.rend) { bf16_t* rowp = A + (size_t)row * FF + col0;
#pragma unroll
                for (int bj = 0; bj < 2; ++bj) { const f32x4 a = acc[ai][bj][m][0], b = acc[ai][bj][m][1]; float o[4];
#pragma unroll
                    for (int j = 0; j < 4; ++j) o[j] = a[j] * __builtin_amdgcn_rcpf(1.0f + __expf(-a[j])) * b[j];
                    u32x2 w; w.x = cvt_pk_bf16(o[0], o[1]); w.y = cvt_pk_bf16(o[2], o[3]);
                    *(u32x2*)(rowp + bj * (HALF / 2)) = w; } } }
    }
};
struct EpiY2 {
    static constexpr bool PERM = true;
    bf16_t* Y; const float* gate;
    __device__ __forceinline__ void operator()(const f32x4 (&acc)[2][2][4][2], const Unit& u, int wr, int wc, int fr, int fq) const {
        const int row0 = u.row0 + wr * 64 + fr, col0 = u.pn * BM + wc * 32 + 8 * fq;
        float gt[2][4];
#pragma unroll
        for (int ai = 0; ai < 2; ++ai)
#pragma unroll
            for (int m = 0; m < 4; ++m) gt[ai][m] = gate[u.loff + min(row0 + ai * HALF + m * 16, u.rend - 1)];
#pragma unroll
        for (int ai = 0; ai < 2; ++ai)
#pragma unroll
            for (int m = 0; m < 4; ++m) { const int row = row0 + ai * HALF + m * 16; if (row < u.rend) { const float g = gt[ai][m]; bf16_t* rowp = Y + (size_t)row * D + col0;
#pragma unroll
                for (int bj = 0; bj < 2; ++bj) { const f32x4 v0 = acc[ai][bj][m][0] * g, v1 = acc[ai][bj][m][1] * g;
                    u32x4 w; w.x = cvt_pk_bf16(v0[0], v0[1]); w.y = cvt_pk_bf16(v0[2], v0[3]); w.z = cvt_pk_bf16(v1[0], v1[1]); w.w = cvt_pk_bf16(v1[2], v1[3]);
                    *(u32x4*)(rowp + bj * HALF) = w; } } }
    }
};

template <class Epi, class Sched>
__device__ __forceinline__ void gemm_phase(LAS unsigned char* lds, const bf16_t* Abase, const int K, const Sched& S, const Epi& E, const int wvid) {
    const int tid = lt_tid(wvid), wid = __builtin_amdgcn_readfirstlane(tid >> 6), lane = tid & 63, wr = wid >> 2, wc = wid & 3, fr = lane & 15, fq = lane >> 4;
    unsigned voffB[2];
#pragma unroll
    for (int i = 0; i < 2; ++i) { int R, C; stage_rc(tid * 16 + i * 8192, R, C); const int Rb = Epi::PERM ? ((R & ~31) + perm32(R & 31)) : R;
        voffB[i] = (unsigned)(Rb * K + C) * 2u; }
    const size_t kstep = (size_t)(BK * 2);
    const size_t hstep = (size_t)HALF * K * 2;
    const unsigned ldsw = (unsigned)wid * 1024u;
    const int aoff = lds_byte(wr * 64 + fr, fq * 8), boff = lds_byte(wc * 32 + fr, fq * 8);
#define PG8_SA(b, h) (((b) * 2 + (h)) * HTB)
#define PG8_SB(b, h) ((4 + (b) * 2 + (h)) * HTB)
#define PG8_STAGE(bufoff, gbase, voff) do { _Pragma("unroll") for (int _i = 0; _i < 2; ++_i) \
        __builtin_amdgcn_global_load_lds((const unsigned*)((const char*)(gbase) + (voff)[_i]), (LAS unsigned*)(lds + (bufoff) + ldsw + _i * 8192), 16, 0, 0); } while (0)
#define PG8_LDA(dst, b, h) do { _Pragma("unroll") for (int m = 0; m < 4; ++m) _Pragma("unroll") for (int k = 0; k < 2; ++k) dst[m][k] = *(const LAS bf16x8*)(lds + PG8_SA(b, h) + aoff + m * 2048 + k * 1024); } while (0)
#define PG8_LDB(dst, b, h) do { _Pragma("unroll") for (int n = 0; n < 2; ++n) _Pragma("unroll") for (int k = 0; k < 2; ++k) dst[n][k] = *(const LAS bf16x8*)(lds + PG8_SB(b, h) + boff + n * 2048 + k * 1024); } while (0)
#define PG8_MMA(ai, bj, At, Bt) do { __builtin_amdgcn_s_setprio(1); _Pragma("unroll") for (int m = 0; m < 4; ++m) _Pragma("unroll") for (int n = 0; n < 2; ++n) _Pragma("unroll") for (int k = 0; k < 2; ++k) \
        acc[ai][bj][m][n] = __builtin_amdgcn_mfma_f32_16x16x32_bf16(Bt[n][k], At[m][k], acc[ai][bj][m][n], 0, 0, 0); __builtin_amdgcn_s_setprio(0); } while (0)
#define PG8_WAIT_V(n) asm volatile("s_waitcnt vmcnt(" #n ")" ::: "memory")
#define PG8_WAIT_L(n) asm volatile("s_waitcnt lgkmcnt(" #n ")" ::: "memory")
#define PG8_BAR __builtin_amdgcn_s_barrier()
#define PG8_SCHED __builtin_amdgcn_sched_barrier(0)
#define PG8_AOFF(u) do { const int _t = lt_tid(wvid); _Pragma("unroll") for (int _i = 0; _i < 2; ++_i) { int _R, _C; stage_rc(_t * 16 + _i * 8192, _R, _C); \
        _Pragma("unroll") for (int _h = 0; _h < 2; ++_h) voffA[_h][_i] = (S.a_row(u, _h * HALF + _R) * (unsigned)K + (unsigned)(_C + (u).koff)) * 2u; } } while (0)
    Unit cur, nxt; int ui = 0;
    if (!S.next(0, cur)) return;
    f32x4 acc[2][2][4][2];
#pragma unroll
    for (int a = 0; a < 2; ++a)
#pragma unroll
        for (int b = 0; b < 2; ++b)
#pragma unroll
            for (int m = 0; m < 4; ++m)
#pragma unroll
                for (int n = 0; n < 2; ++n) acc[a][b][m][n] = (f32x4){0.f, 0.f, 0.f, 0.f};
    bf16x8 At[4][2], B0[2][2], B1[2][2];
    unsigned voffA[2][2];
    PG8_AOFF(cur);
    const char* Ab = (const char*)Abase;
    const char* cB = S.b_ptr(cur);
    PG8_STAGE(PG8_SB(0, 0), cB, voffB); PG8_STAGE(PG8_SA(0, 0), Ab, voffA[0]); PG8_STAGE(PG8_SB(0, 1), cB + hstep, voffB); PG8_STAGE(PG8_SA(0, 1), Ab, voffA[1]);
    if (wr == 1) PG8_BAR;
    PG8_WAIT_V(4); PG8_BAR;
    PG8_STAGE(PG8_SB(1, 0), cB + kstep, voffB); PG8_STAGE(PG8_SA(1, 0), Ab + kstep, voffA[0]); PG8_STAGE(PG8_SB(1, 1), cB + hstep + kstep, voffB);
    PG8_WAIT_V(6); PG8_BAR;
    for (;;) {
        const bool has_next = S.next(ui + 1, nxt);
        const char* nB = has_next ? S.b_ptr(nxt) : cB;
        const int nt = cur.kt;
        for (int t = 0; t < nt; t += 2) {
            const bool last = (t == nt - 2);
            const char* a1 = Ab + (size_t)(t + 1) * kstep;
            PG8_LDB(B0, 0, 0); PG8_SCHED; PG8_LDA(At, 0, 0); PG8_STAGE(PG8_SA(1, 1), a1, voffA[1]);
            PG8_WAIT_L(8); PG8_BAR; PG8_WAIT_L(0); PG8_MMA(0, 0, At, B0); PG8_BAR; PG8_SCHED;
            if (last && has_next) PG8_AOFF(nxt);
            const char* a2 = last ? Ab : Ab + (size_t)(t + 2) * kstep; const char* b2 = last ? nB : cB + (size_t)(t + 2) * kstep;
            const char* a3 = a2 + kstep; const char* b3 = b2 + kstep;
            PG8_LDB(B1, 0, 1); PG8_STAGE(PG8_SB(0, 0), b2, voffB);
            PG8_BAR; PG8_WAIT_L(0); PG8_MMA(0, 1, At, B1); PG8_BAR;
            PG8_LDA(At, 0, 1); PG8_STAGE(PG8_SA(0, 0), a2, voffA[0]);
            PG8_BAR; PG8_WAIT_L(0); PG8_MMA(1, 0, At, B0); PG8_BAR; PG8_SCHED;
            PG8_STAGE(PG8_SB(0, 1), b2 + hstep, voffB);
            PG8_WAIT_V(6); PG8_BAR; PG8_MMA(1, 1, At, B1); PG8_BAR;
            PG8_LDB(B0, 1, 0); PG8_SCHED; PG8_LDA(At, 1, 0); PG8_STAGE(PG8_SA(0, 1), a2, voffA[1]);
            PG8_WAIT_L(8); PG8_BAR; PG8_WAIT_L(0); PG8_MMA(0, 0, At, B0); PG8_BAR; PG8_SCHED;
            PG8_LDB(B1, 1, 1); PG8_STAGE(PG8_SB(1, 0), b3, voffB);
            PG8_BAR; PG8_WAIT_L(0); PG8_MMA(0, 1, At, B1); PG8_BAR;
            PG8_LDA(At, 1, 1); PG8_STAGE(PG8_SA(1, 0), a3, voffA[0]);
            PG8_BAR; PG8_WAIT_L(0); PG8_MMA(1, 0, At, B0); PG8_BAR; PG8_SCHED;
            PG8_STAGE(PG8_SB(1, 1), b3 + hstep, voffB);
            PG8_WAIT_V(6); PG8_BAR; PG8_MMA(1, 1, At, B1); PG8_BAR;
        }
        E(acc, cur, wr, wc, fr, fq);
        if (!has_next) break;
#pragma unroll
        for (int a = 0; a < 2; ++a)
#pragma unroll
            for (int b = 0; b < 2; ++b)
#pragma unroll
                for (int m = 0; m < 4; ++m)
#pragma unroll
                    for (int n = 0; n < 2; ++n) acc[a][b][m][n] = (f32x4){0.f, 0.f, 0.f, 0.f};
        cur = nxt; cB = nB; ++ui;
    }
    PG8_WAIT_V(0);
    if (wr == 0) PG8_BAR;
    PG8_BAR;
#undef PG8_SA
#undef PG8_SB
#undef PG8_STAGE
#undef PG8_LDA
#undef PG8_LDB
#undef PG8_MMA
#undef PG8_WAIT_V
#undef PG8_WAIT_L
#undef PG8_BAR
#undef PG8_SCHED
#undef PG8_AOFF
}
}

constexpr int NTHR = 512, NWAVE = 8;
constexpr int LDS_BYTES = 155648;

struct TrItem { const float* W; bf16_t* WT; int K, N, mode, item; };
__device__ __forceinline__ void tr_load(const TrItem& t, float (&v)[32], int lane) {
    const int nblk = t.N / 32, kb = t.item / nblk, nb = t.item % nblk, k0 = 64 * kb, n0 = 32 * nb;
#pragma unroll
    for (int i = 0; i < 32; ++i) v[i] = t.W[(size_t)(k0 + 2 * i + (lane >> 5)) * t.N + n0 + (lane & 31)];
}
__device__ __forceinline__ void tr_finish(const TrItem& t, const float (&v)[32], LAS float* scr, int lane) {
    const int nblk = t.N / 32, kb = t.item / nblk, nb = t.item % nblk, k0 = 64 * kb, n0 = 32 * nb;
#pragma unroll
    for (int i = 0; i < 32; ++i) scr[(2 * i + (lane >> 5)) * 33 + (lane & 31)] = v[i];
    asm volatile("s_waitcnt lgkmcnt(0)" ::: "memory");
    const int c = lane & 7;
#pragma unroll
    for (int j = 0; j < 4; ++j) { const int n = (lane >> 3) + 8 * j; const LAS float* s = scr + (8 * c) * 33 + n;
        u32x4 o; o.x = pk2(s[0 * 33], s[1 * 33]); o.y = pk2(s[2 * 33], s[3 * 33]); o.z = pk2(s[4 * 33], s[5 * 33]); o.w = pk2(s[6 * 33], s[7 * 33]);
        const int ng = n0 + n; const int row = t.mode == 0 ? ng : (8 * (ng >> 2) + (ng & 3) + (t.mode == 2 ? 4 : 0));
        *(u32x4*)(t.WT + (size_t)row * t.K + k0 + 8 * c) = o; }
    asm volatile("s_waitcnt lgkmcnt(0)" ::: "memory");
}
struct LnPar { f32x4 g[4], b[4]; };
__device__ __forceinline__ LnPar ln_par(const float* g, const float* b, int lane) { LnPar q;
#pragma unroll
    for (int j = 0; j < 4; ++j) { q.g[j] = *(const f32x4*)(g + 4 * lane + 256 * j); q.b[j] = *(const f32x4*)(b + 4 * lane + 256 * j); }
    return q; }
__device__ __forceinline__ void ln_affine(f32x4 (&v)[4], const LnPar& q) {
    float s = 0.f;
#pragma unroll
    for (int j = 0; j < 4; ++j) s += (v[j][0] + v[j][1]) + (v[j][2] + v[j][3]);
    const float mean = wave_sum(s) * (1.f / D); float s2 = 0.f;
#pragma unroll
    for (int j = 0; j < 4; ++j) { v[j] = v[j] - mean; s2 += (v[j][0] * v[j][0] + v[j][1] * v[j][1]) + (v[j][2] * v[j][2] + v[j][3] * v[j][3]); }
    const float rstd = frsq(wave_sum(s2) * (1.f / D) + 1e-5f);
#pragma unroll
    for (int j = 0; j < 4; ++j) v[j] = v[j] * rstd * q.g[j] + q.b[j];
}
__device__ __forceinline__ void store_row_bf16(bf16_t* row, const f32x4 (&v)[4], int lane) {
#pragma unroll
    for (int j = 0; j < 4; ++j) { u32x2 w; w.x = pk2(v[j][0], v[j][1]); w.y = pk2(v[j][2], v[j][3]); *(u32x2*)(row + 4 * lane + 256 * j) = w; }
}
constexpr int TRN_WIN = 16 * 88, TRN_WOUT = 16 * 32, TRN_W1 = 16 * 16, TRN_W2 = 8 * 32, TRN_EXP = 2 * TRN_W1 + TRN_W2, TRN_LAYER = TRN_WIN + TRN_WOUT + NE * TRN_EXP;
template <int GRP> __device__ __forceinline__ constexpr int tr_count() {
    return GRP == 0 ? TRN_WIN : GRP == 1 ? TRN_WOUT + 4 * 2 * TRN_W1 : GRP == 2 ? NE * TRN_W2 + TRN_WIN + TRN_WOUT : GRP == 5 ? NE * TRN_W2 : GRP == 6 ? 7 * 2 * TRN_W1 : GRP == 7 ? 5 * 2 * TRN_W1 : (NE / 2) * 2 * TRN_W1; }
template <int GRP> __device__ __forceinline__ int tr_index(int g) {
    constexpr int EX0 = TRN_WIN + TRN_WOUT, W13N = 2 * TRN_W1;
    if (GRP == 0) return g;
    if (GRP == 1) { if (g < TRN_WOUT) return TRN_WIN + g; const int q = g - TRN_WOUT; return EX0 + (q / W13N) * TRN_EXP + q % W13N; }
    if (GRP == 6) return EX0 + (4 + g / W13N) * TRN_EXP + g % W13N;
    if (GRP == 7) return EX0 + (11 + g / W13N) * TRN_EXP + g % W13N;
    if (GRP == 2) { if (g < NE * TRN_W2) return EX0 + (g / TRN_W2) * TRN_EXP + W13N + g % TRN_W2; return TRN_LAYER + (g - NE * TRN_W2); }
    if (GRP == 3 || GRP == 4) return TRN_LAYER + EX0 + ((GRP == 4 ? NE / 2 : 0) + g / W13N) * TRN_EXP + g % W13N;
    return TRN_LAYER + EX0 + (g / TRN_W2) * TRN_EXP + W13N + g % TRN_W2;
}
__device__ __forceinline__ TrItem tr_decode(const Params& p, unsigned char* ws, int it) {
    bf16_t* WIN = (bf16_t*)(ws + WS_WIN); bf16_t* WOUT = (bf16_t*)(ws + WS_WOUT); bf16_t* W13 = (bf16_t*)(ws + WS_W13); bf16_t* W2 = (bf16_t*)(ws + WS_W2);
    const int l = it / TRN_LAYER; int r = it % TRN_LAYER; TrItem t;
    if (r < TRN_WIN) { t.W = p.in[I_WIN] + (size_t)l * D * INW; t.WT = WIN + (size_t)l * INW * D; t.K = D; t.N = INW; t.mode = 0; t.item = r; return t; } r -= TRN_WIN;
    if (r < TRN_WOUT) { t.W = p.in[I_WOUT] + (size_t)l * D * D; t.WT = WOUT + (size_t)l * D * D; t.K = D; t.N = D; t.mode = 0; t.item = r; return t; } r -= TRN_WOUT;
    const int e = r / TRN_EXP, q = r % TRN_EXP; const size_t le = (size_t)l * NE + e;
    if (q < TRN_W1) { t.W = p.in[I_EW1] + le * D * FF; t.WT = W13 + le * 1024 * 1024; t.K = D; t.N = FF; t.mode = 1; t.item = q; }
    else if (q < 2 * TRN_W1) { t.W = p.in[I_EW3] + le * D * FF; t.WT = W13 + le * 1024 * 1024; t.K = D; t.N = FF; t.mode = 2; t.item = q - TRN_W1; }
    else { t.W = p.in[I_EW2] + le * FF * D; t.WT = W2 + le * 1024 * FF; t.K = FF; t.N = D; t.mode = 0; t.item = q - 2 * TRN_W1; }
    return t;
}
template <int GRP> __device__ __forceinline__ void tr_group(const Params& p, unsigned char* ws, LAS float* scr, int lane, int start, int stride) {
    float cur[32], nx1[32], nx2[32]; int g = start; constexpr int N = tr_count<GRP>();
    if (g < N) { const TrItem t0 = tr_decode(p, ws, tr_index<GRP>(g)); tr_load(t0, cur, lane); }
    if (g + stride < N) { const TrItem t1 = tr_decode(p, ws, tr_index<GRP>(g + stride)); tr_load(t1, nx1, lane); }
    while (g < N) { const int g2 = g + 2 * stride;
        if (g2 < N) { const TrItem tn = tr_decode(p, ws, tr_index<GRP>(g2)); tr_load(tn, nx2, lane); }
        const TrItem tc = tr_decode(p, ws, tr_index<GRP>(g)); tr_finish(tc, cur, scr, lane);
#pragma unroll
        for (int i = 0; i < 32; ++i) { cur[i] = nx1[i]; nx1[i] = nx2[i]; }
        g += stride; }
}
template <int GRP> __device__ __forceinline__ void tr_in_rwkv_idle(const Params& p, unsigned char* ws, LAS unsigned char* lds, int bid, const int wvid) {
    if ((bid & 7) == 0) return;
    const int G = (int)gridDim.x, n = G - (G + 7) / 8, rank = bid - (bid >> 3) - 1;
    __syncthreads();
    const int tid = lt_tid(wvid), lane = tid & 63, wave = tid >> 6;
    tr_group<GRP>(p, ws, (LAS float*)(lds + wave * 8704), lane, rank * NWAVE + wave, n * NWAVE);
}
template <int GRP> __device__ __forceinline__ void tr_in_tail(const Params& p, unsigned char* ws, LAS unsigned char* lds, int total, int bid, const int wvid) {
    const int G = (int)gridDim.x, R = (total + G - 1) / G, c0 = total - (R - 1) * G;
    const int first = c0 >= G ? 0 : c0, n = G - first;
    if (bid < first) return;
    const int tid = lt_tid(wvid), lane = tid & 63, wave = tid >> 6;
    tr_group<GRP>(p, ws, (LAS float*)(lds + wave * 8704), lane, (bid - first) * NWAVE + wave, n * NWAVE);
}
__device__ __forceinline__ void ph_prologue(const Params& p, LAS unsigned char* lds, const int wvid) {
    const int bid = lt_bid(); unsigned char* const ws = lt_ptr(p.ws); (void)bid; (void)ws;
    const int tid = lt_tid(wvid), lane = tid & 63, wave = tid >> 6, gw = bid * NWAVE + wave, NGW = gridDim.x * NWAVE;
    LAS float* scr = (LAS float*)(lds + wave * 8704);
    tr_group<0>(p, ws, scr, lane, gw, NGW);
    {
        bf16_t* VT = (bf16_t*)(ws + WS_VTD);
        for (int i = bid * NTHR + tid; i < NB * 6 * 64 * (LTP - LT); i += gridDim.x * NTHR) { const int r = i / (LTP - LT), k = i % (LTP - LT); VT[(size_t)r * LTP + LT + k] = 0; }
    }
    {
        bf16_t* LW = (bf16_t*)(ws + WS_LORA);
        for (int i = bid * NTHR + tid; i < NLAYER * 65536; i += gridDim.x * NTHR) {
            const int l = i >> 16, r = i & 65535; float v;
            if (r < 16384) { const int c = r >> 6, k = r & 63; v = p.in[I_W2][(size_t)l * 16384 + k * 256 + c]; }
            else if (r < 32768) { const int q = r - 16384, c = q >> 6, k = q & 63; v = p.in[I_A2][(size_t)l * 16384 + k * 256 + c]; }
            else { const int q = r - 32768, c = q >> 7, k = q & 127; v = p.in[I_G2][(size_t)l * 32768 + k * 256 + c]; }
            LW[i] = f2bf(v); }
    }
    bf16_t* HB = (bf16_t*)(ws + WS_HB); bf16_t* MIX = (bf16_t*)(ws + WS_MIX);
    const LnPar ln0 = ln_par(p.in[I_LN0G], p.in[I_LN0B], lane);
    auto row_src = [&](int r) -> const float* { const int rc = r < T ? r : 0; const int b = rc / LT, t = rc % LT; return t < NMETA ? p.in[I_META] + (size_t)t * D : p.in[I_X] + ((size_t)b * SEQ + (t - NMETA)) * D; };
    f32x4 vn[4];
    { const float* src = row_src(gw);
#pragma unroll
      for (int j = 0; j < 4; ++j) vn[j] = *(const f32x4*)(src + 4 * lane + 256 * j); }
    for (int r = gw; r < MP; r += NGW) {
        f32x4 v[4];
        { const float* src = row_src(r + NGW < MP ? r + NGW : r);
#pragma unroll
          for (int j = 0; j < 4; ++j) { v[j] = vn[j]; vn[j] = *(const f32x4*)(src + 4 * lane + 256 * j); } }
        if (r >= T) {
#pragma unroll
            for (int j = 0; j < 4; ++j) v[j] = (f32x4){0.f, 0.f, 0.f, 0.f};
            store_row_bf16(MIX + (size_t)r * D, v, lane);
        } else ln_affine(v, ln0);
        store_row_bf16(HB + (size_t)r * D, v, lane);
    }
}

__device__ __forceinline__ void ph_gemm_in(const Params& p, int l, LAS unsigned char* lds, const int wvid) {
    const int bid = lt_bid(); unsigned char* const ws = lt_ptr(p.ws); (void)bid; (void)ws;
    pg8::DenseOrder S; S.init(MP, INW, D, (const bf16_t*)(ws + WS_WIN) + (size_t)l * INW * D, gridDim.x, bid);
    pg8::EpiU E{(bf16_t*)(ws + WS_U), (bf16_t*)(ws + WS_VTD), (bf16_t*)(ws + WS_VTA)};
    pg8::gemm_phase(lds, (const bf16_t*)(ws + WS_HB), D, S, E, wvid);
    if (l == 0) tr_in_tail<1>(p, ws, lds, (MP / 256) * (INW / 256), bid, wvid); else tr_in_tail<4>(p, ws, lds, (MP / 256) * (INW / 256), bid, wvid);
}
__device__ __forceinline__ void ph_gemm_out(const Params& p, int l, LAS unsigned char* lds, const int wvid) {
    const int bid = lt_bid(); unsigned char* const ws = lt_ptr(p.ws); (void)bid; (void)ws;
    pg8::DenseOrder S; S.init(MP, D, D, (const bf16_t*)(ws + WS_WOUT) + (size_t)l * D * D, gridDim.x, bid, ZSPLIT);
    pg8::EpiZ E{(bf16_t*)(ws + WS_Z), (const bf16_t*)(ws + WS_HB), (float*)(ws + WS_ZP), D};
    pg8::gemm_phase(lds, (const bf16_t*)(ws + WS_MIX), D, S, E, wvid);
}
__device__ __forceinline__ void moe_table(unsigned char* ws, int l, LAS int* tab, const int wvid) {
    const int t = lt_tid(wvid);
    __syncthreads();
    if (t < 16) tab[40 + t] = (int)__hip_atomic_load((const unsigned*)(ws + WS_CTL) + CW_CNT + l * 16 + t, __ATOMIC_RELAXED, __HIP_MEMORY_SCOPE_AGENT);
    __syncthreads();
    if (t == 0) {
        int ts = 0, ss = 0;
        for (int e = 0; e < 16; ++e) { const int c = tab[40 + e]; tab[e] = ts; tab[17 + e] = ss; ts += (c + 255) >> 8; ss += c; }
        tab[16] = ts; tab[33] = ss;
    }
    __syncthreads();
}
__device__ __forceinline__ void ph_gemm1(const Params& p, int l, LAS unsigned char* lds, const int wvid) {
    const int bid = lt_bid(); unsigned char* const ws = lt_ptr(p.ws); (void)bid; (void)ws;
    LAS int* tab = (LAS int*)(lds + pg8::STAGE_BYTES);
    moe_table(ws, l, tab, wvid);
    pg8::MoeOrder S{tab, 4, (int)gridDim.x, (int)bid, (const bf16_t*)(ws + WS_W13) + (size_t)l * NE * 1024 * 1024, (size_t)1024 * 1024, D, (const int*)(ws + WS_LIST)};
    pg8::EpiAct E{(bf16_t*)(ws + WS_ACT)};
    pg8::gemm_phase(lds, (const bf16_t*)(ws + WS_HB), D, S, E, wvid);
    if (l == 0) tr_in_tail<2>(p, ws, lds, tab[16] * 4, bid, wvid); else tr_in_tail<5>(p, ws, lds, tab[16] * 4, bid, wvid);
}
__device__ __forceinline__ void ph_gemm2(const Params& p, int l, LAS unsigned char* lds, const int wvid) {
    const int bid = lt_bid(); unsigned char* const ws = lt_ptr(p.ws); (void)bid; (void)ws;
    LAS int* tab = (LAS int*)(lds + pg8::STAGE_BYTES);
    moe_table(ws, l, tab, wvid);
    pg8::MoeOrder S{tab, 4, (int)gridDim.x, (int)bid, (const bf16_t*)(ws + WS_W2) + (size_t)l * NE * 1024 * FF, (size_t)1024 * FF, FF, nullptr};
    pg8::EpiY2 E{(bf16_t*)(ws + WS_Y2), (const float*)(ws + WS_GSL)};
    pg8::gemm_phase(lds, (const bf16_t*)(ws + WS_ACT), FF, S, E, wvid);
    if (l == 0) tr_in_tail<3>(p, ws, lds, tab[16] * 4, bid, wvid);
}

__device__ __forceinline__ void load8(const bf16_t* p, float* o) { const u32x4 w = *(const u32x4*)p; o[0] = bflo(w.x); o[1] = bfhi(w.x); o[2] = bflo(w.y); o[3] = bfhi(w.y); o[4] = bflo(w.z); o[5] = bfhi(w.z); o[6] = bflo(w.w); o[7] = bfhi(w.w); }
template <int NH>
__device__ __forceinline__ void vt_pass(const bf16_t* U, bf16_t* VT, int colbase, LAS unsigned char* lds, int bid, int tid) {
    constexpr int PITCH = NH * 128 + 16, NCH = NH * 8  , NIT = 64 * NCH / NTHR;
    for (int unit = bid; unit < NB * (LTP / 64); unit += gridDim.x) {
        const int b = unit / (LTP / 64), k0 = (unit % (LTP / 64)) * 64;
        __syncthreads();
#pragma unroll
        for (int q = 0; q < NIT; ++q) { const int it = tid + q * NTHR, row = it / NCH, ch = it % NCH;
            u32x4 v = *(const u32x4*)(U + ((size_t)b * LT + min(k0 + row, LT - 1)) * INW + colbase + ch * 8);
            if (k0 + row >= LT) v = (u32x4){0u, 0u, 0u, 0u};
            *(LAS u32x4*)(lds + row * PITCH + ch * 16) = v; }
        __syncthreads();
#pragma unroll
        for (int q = 0; q < NIT; ++q) { const int it = tid + q * NTHR, col = it >> 3, g = (it >> 1) & 3, hh = it & 1;
            unsigned short e[8];
#pragma unroll
            for (int j = 0; j < 8; ++j) { const int key = 16 * g + 8 * (j >> 2) + 4 * hh + (j & 3); e[j] = *(const LAS unsigned short*)(lds + key * PITCH + col * 2); }
            u32x4 o; o.x = e[0] | ((unsigned)e[1] << 16); o.y = e[2] | ((unsigned)e[3] << 16); o.z = e[4] | ((unsigned)e[5] << 16); o.w = e[6] | ((unsigned)e[7] << 16);
            *(u32x4*)(VT + ((size_t)(b * NH + (col >> 6)) * 64 + (col & 63)) * LTP + k0 + 16 * g + 8 * hh) = o; }
    }
    __syncthreads();
}
__device__ __forceinline__ void ph_vt(const Params& p, int l, LAS unsigned char* lds, const int wvid) {
    const int bid = lt_bid(); unsigned char* const ws = lt_ptr(p.ws);
    const int tid = lt_tid(wvid);
    const int G_ = (int)gridDim.x;

    {   const bf16_t* U = (const bf16_t*)(ws + WS_U); unsigned* kmx = (unsigned*)(ws + WS_CTL) + CW_KMX + l * 256;
        LAS unsigned* lm = (LAS unsigned*)lds;
        for (int unit = (bid + G_ - 16) % G_; unit < NB * (LTP / 64); unit += gridDim.x) {
            const int b = unit / (LTP / 64), k0 = (unit % (LTP / 64)) * 64;
            __syncthreads();
            if (tid < 16) lm[tid] = 0u;
            __syncthreads();
            const int row = tid >> 3, g = tid & 7; const size_t ro = ((size_t)b * LT + min(k0 + row, LT - 1)) * INW;
            float n2 = 0.f, n2a = 0.f;
#pragma unroll
            for (int i = 0; i < 4; ++i) { float x[8]; load8(U + ro + C_KD + g * 32 + 8 * i, x);
#pragma unroll
                for (int e = 0; e < 8; ++e) n2 += x[e] * x[e]; }
#pragma unroll
            for (int i = 0; i < 2; ++i) { float x[8]; load8(U + ro + C_KA + g * 16 + 8 * i, x);
#pragma unroll
                for (int e = 0; e < 8; ++e) n2a += x[e] * x[e]; }
            n2a += __shfl_xor(n2a, 1); n2a += __shfl_xor(n2a, 2);
            if (k0 + row < LT) { __hip_atomic_fetch_max(lm + g, __float_as_uint(n2), __ATOMIC_RELAXED, __HIP_MEMORY_SCOPE_WORKGROUP);
                if ((g & 3) == 0) __hip_atomic_fetch_max(lm + 8 + (g >> 2), __float_as_uint(n2a), __ATOMIC_RELAXED, __HIP_MEMORY_SCOPE_WORKGROUP); }
            __syncthreads();
            if (tid < 10) __hip_atomic_fetch_max(kmx + (tid < 8 ? b * 8 + tid : 128 + b * 2 + (tid - 8)), lm[tid], __ATOMIC_RELAXED, __HIP_MEMORY_SCOPE_AGENT);
        }
        __syncthreads();
    }
}

typedef float f32x16 __attribute__((ext_vector_type(16)));
typedef float f32x2_t __attribute__((ext_vector_type(2))); typedef __bf16 bf16x2_t __attribute__((ext_vector_type(2)));
__device__ __forceinline__ unsigned pkbf(float lo, float hi) { f32x2_t v = {lo, hi}; bf16x2_t b = __builtin_convertvector(v, bf16x2_t); return __builtin_bit_cast(unsigned, b); }
__device__ __forceinline__ bf16x8 pack_acc(const f32x16& a, int s) {
    u32x4 w; w.x = pkbf(a[8 * s], a[8 * s + 1]); w.y = pkbf(a[8 * s + 2], a[8 * s + 3]); w.z = pkbf(a[8 * s + 4], a[8 * s + 5]); w.w = pkbf(a[8 * s + 6], a[8 * s + 7]);
    return __builtin_bit_cast(bf16x8, w);
}
constexpr int DF_PITCH = 144, DF_KB = 64 * DF_PITCH;
__device__ __forceinline__ void diff_tile(const bool near, const LAS unsigned char* Kb, const LAS unsigned char* Vb, const LAS float* btab, const LAS bf16x8* Qs, f32x16 (&O)[2][2],
                                          const float (&mref)[2], float (&lsum)[2], int qpos, int k0, int l31, int hi, float c2, float farb) {
    float bm[2][16];
    if (near) {
#pragma unroll
        for (int kb = 0; kb < 2; ++kb)
#pragma unroll
            for (int r = 0; r < 16; ++r) { const int dist = qpos - (k0 + 32 * kb + (r & 3) + 8 * (r >> 2) + 4 * hi); bm[kb][r] = btab[min(max(dist, 0), 128)]; }
#pragma unroll
        for (int kb = 0; kb < 2; ++kb)
#pragma unroll
            for (int r = 0; r < 16; ++r) { asm volatile("" : "+v"(bm[kb][r]));
                const int dist = qpos - (k0 + 32 * kb + (r & 3) + 8 * (r >> 2) + 4 * hi); bm[kb][r] = dist < 0 ? -INFINITY : bm[kb][r]; }
    } else {
#pragma unroll
        for (int kb = 0; kb < 2; ++kb)
#pragma unroll
            for (int r = 0; r < 16; ++r) bm[kb][r] = 0.f;
    }
    bf16x8 Vf[4][2];
#pragma unroll
    for (int st = 0; st < 4; ++st)
#pragma unroll
        for (int dvb = 0; dvb < 2; ++dvb) Vf[st][dvb] = *(const LAS bf16x8*)(Vb + (32 * dvb + l31) * DF_PITCH + st * 32 + hi * 16);
#pragma unroll
    for (int c = 0; c < 2; ++c) {
        f32x16 S[2];
#pragma unroll
        for (int kb = 0; kb < 2; ++kb) {
            f32x16 acc;
#pragma unroll
            for (int r = 0; r < 16; ++r) acc[r] = 0.f;
#pragma unroll
            for (int s = 0; s < 2; ++s) { const bf16x8 kf = *(const LAS bf16x8*)(Kb + (32 * kb + l31) * DF_PITCH + c * 64 + s * 32 + hi * 16);
                acc = __builtin_amdgcn_mfma_f32_32x32x16_bf16(kf, Qs[(c * 2 + s) * 64], acc, 0, 0, 0); }
            S[kb] = acc;
        }
        if (near) {
#pragma unroll
            for (int kb = 0; kb < 2; ++kb)
#pragma unroll
                for (int r = 0; r < 16; ++r) S[kb][r] += bm[kb][r]; }
        const float ad = (near ? 0.f : farb) - mref[c];
        float ls = 0.f;
        bf16x8 Pf[4];
#pragma unroll
        for (int kb = 0; kb < 2; ++kb) {
#pragma unroll
            for (int r = 0; r < 16; ++r) { const float pv = __builtin_amdgcn_exp2f(S[kb][r] * c2 + ad); ls += pv; S[kb][r] = pv; }
#pragma unroll
            for (int s = 0; s < 2; ++s) Pf[2 * kb + s] = pack_acc(S[kb], s);
        }
        lsum[c] += ls;
#pragma unroll
        for (int st = 0; st < 4; ++st)
#pragma unroll
            for (int dvb = 0; dvb < 2; ++dvb) O[c][dvb] = __builtin_amdgcn_mfma_f32_32x32x16_bf16(Vf[st][dvb], Pf[st], O[c][dvb], 0, 0, 0);
    }
}
__device__ __forceinline__ void ph_diff2(const Params& p, int l, LAS unsigned char* lds, const int wvid, const int qslot = 0) {
    const int bid = lt_bid(); unsigned char* const ws = lt_ptr(p.ws); (void)bid;
    const int tid = lt_tid(wvid), lane = tid & 63, wave = __builtin_amdgcn_readfirstlane(tid >> 6), l31 = lane & 31, hi = lane >> 5;
    const bf16_t* U = (const bf16_t*)(ws + WS_U); const bf16_t* VT = (const bf16_t*)(ws + WS_VTD); bf16_t* MIX = (bf16_t*)(ws + WS_MIX);
    unsigned* qhead = (unsigned*)(ws + WS_CTL) + CW_DQ + (qslot * 4 + l) * 64;
    LAS float* btab = (LAS float*)lds;
    LAS int* ucur = (LAS int*)(lds + 4 * 132 * 4);
    LAS unsigned char* KV = lds + 4096;
    constexpr float LOG2E = 1.4426950408889634f;
    for (int i = tid; i < 4 * 129; i += NTHR) { const int h = i / 129, n = i % 129; btab[h * 132 + n] = p.in[I_RELB][t5_bucket(n) * 8 + 4 + h] * 5.656854249492381f; }
    if (tid < 4) { float bx = -1e30f; for (int n = 0; n < 32; ++n) bx = fmaxf(bx, p.in[I_RELB][n * 8 + 4 + tid]); btab[tid * 132 + 129] = bx * 5.656854249492381f; }
    float s1 = 0.f, s2 = 0.f;
    for (int i = 0; i < 32; ++i) { s1 += p.in[I_LQ1][l * 32 + i] * p.in[I_LK1][l * 32 + i]; s2 += p.in[I_LQ2][l * 32 + i] * p.in[I_LK2][l * 32 + i]; }
    const float lam_init = 0.8f - 0.6f * expf(-0.3f * (float)l), lam = expf(s1) - expf(s2) + lam_init;
    const float c2 = 0.17677669529663687f * LOG2E;
    const int krow = tid >> 3, kch = tid & 7;
    for (;;) {
        __syncthreads();
        if (tid == 0) *ucur = (int)atomicAdd(qhead, 1u);
        __syncthreads();
        const int u = *ucur;
        if (u >= 17 * 32) break;
        const int qi = 16 - u / 32, bh = u % 32, b = bh >> 2, h = bh & 3;
        const int q0 = qi == 0 ? 0 : 16 + 256 * (qi - 1), nkt = qi == 0 ? 1 : 4 * qi + 1;
        const int q0w = q0 + 32 * wave, qpos = q0w + l31;
        const bool wave_on = (qi > 0) || (wave == 0);
        const size_t qrow = (size_t)b * LT + (qpos < LT ? qpos : LT - 1);
        LAS bf16x8* Qs = (LAS bf16x8*)(lds + 4096 + 4 * DF_KB) + wave * 256 + lane;
        float mref[2];
        { const unsigned* kmx = (const unsigned*)(ws + WS_CTL) + CW_KMX + l * 256 + b * 8 + h * 2;
#pragma unroll
          for (int c = 0; c < 2; ++c) { float qn2 = 0.f;
#pragma unroll
              for (int s = 0; s < 2; ++s) { const u32x4 qv = *(const u32x4*)(U + qrow * INW + C_QD + h * 64 + c * 32 + s * 16 + hi * 8); Qs[(c * 2 + s) * 64] = __builtin_bit_cast(bf16x8, qv);
                  const unsigned qw[4] = {qv.x, qv.y, qv.z, qv.w};
#pragma unroll
                  for (int e = 0; e < 4; ++e) qn2 += bflo(qw[e]) * bflo(qw[e]) + bfhi(qw[e]) * bfhi(qw[e]); }
              qn2 += __shfl_xor(qn2, 32);
              const float km2 = __uint_as_float(__hip_atomic_load(kmx + c, __ATOMIC_RELAXED, __HIP_MEMORY_SCOPE_AGENT));
              mref[c] = (sqrtf(qn2 * km2) * 1.001f + btab[h * 132 + 129]) * c2; } }
        f32x16 O[2][2]; float lsum[2] = {0.f, 0.f};
#pragma unroll
        for (int c = 0; c < 2; ++c)
#pragma unroll
            for (int d = 0; d < 2; ++d)
#pragma unroll
                for (int r = 0; r < 16; ++r) O[c][d][r] = 0.f;
        const bf16_t* kbase = U + (size_t)b * LT * INW + C_KD + h * 64;
        const bf16_t* vbase = VT + (size_t)bh * 64 * LTP;
        const unsigned koff = (unsigned)(krow * INW + kch * 8), voff = (unsigned)(krow * LTP + kch * 8);
        const float farb = btab[h * 132 + 128] * c2;
        u32x4 kreg = *(const u32x4*)(kbase + koff), vreg = *(const u32x4*)(vbase + voff);
        *(LAS u32x4*)(KV + krow * DF_PITCH + kch * 16) = kreg; *(LAS u32x4*)(KV + 2 * DF_KB + krow * DF_PITCH + kch * 16) = vreg;
        __syncthreads();
        for (int kt = 0; kt < nkt; ++kt) {
            const int k0 = kt * 64, cur = kt & 1;
            if (kt + 1 < nkt) { kreg = *(const u32x4*)(kbase + (koff + (unsigned)((k0 + 64) * INW))); vreg = *(const u32x4*)(vbase + (voff + (unsigned)(k0 + 64))); }
            if (wave_on && k0 <= q0w + 31) {
                const LAS unsigned char* Kb = KV + cur * DF_KB; const LAS unsigned char* Vb = KV + (2 + cur) * DF_KB;
                diff_tile(q0w - (k0 + 63) < 113, Kb, Vb, btab + h * 132, Qs, O, mref, lsum, qpos, k0, l31, hi, c2, farb);
            }
            if (kt + 1 < nkt) { *(LAS u32x4*)(KV + (cur ^ 1) * DF_KB + krow * DF_PITCH + kch * 16) = kreg; *(LAS u32x4*)(KV + (2 + (cur ^ 1)) * DF_KB + krow * DF_PITCH + kch * 16) = vreg; }
            __syncthreads();
        }
        const float l0 = lsum[0] + __shfl_xor(lsum[0], 32), l1 = lsum[1] + __shfl_xor(lsum[1], 32);
        const float i0 = 1.0f / l0, i1 = lam / l1;
        float ss = 0.f;
#pragma unroll
        for (int d = 0; d < 2; ++d)
#pragma unroll
            for (int r = 0; r < 16; ++r) { const float o = O[0][d][r] * i0 - O[1][d][r] * i1; O[0][d][r] = o; ss += o * o; }
        ss += __shfl_xor(ss, 32);
        const float rn = frsq(ss * (1.f / 64.f) + 1e-5f) * (1.0f - lam_init);
        const int lane2 = lt_tid(wvid) & 63, qpos2 = q0w + (lane2 & 31), hi2 = lane2 >> 5;
        if (wave_on && qpos2 < LT && (qi > 0 || qpos2 < NMETA)) {
            bf16_t* orow = MIX + ((size_t)b * LT + qpos2) * D + M_B + h * 64;
#pragma unroll
            for (int d = 0; d < 2; ++d)
#pragma unroll
                for (int g4 = 0; g4 < 4; ++g4) { const int dv0 = 32 * d + 8 * g4 + 4 * hi2; const f32x4 gg = *(const f32x4*)(p.in[I_SUBLN] + l * 64 + dv0);
                    u32x2 w; w.x = pkbf(O[0][d][4 * g4] * rn * gg[0], O[0][d][4 * g4 + 1] * rn * gg[1]); w.y = pkbf(O[0][d][4 * g4 + 2] * rn * gg[2], O[0][d][4 * g4 + 3] * rn * gg[3]);
                    *(u32x2*)(orow + dv0) = w; }
        }
    }
    __syncthreads();
}


__device__ __forceinline__ void swa_tile(const LAS unsigned char* Kb, const LAS unsigned char* Vb, const LAS float* btab, const bf16x8 (&Qf)[4], f32x16 (&O)[2],
                                         float& m, float& lsum, int qpos, int k0, int l31, int hi, float c2) {
    f32x16 S[2];
#pragma unroll
    for (int kb = 0; kb < 2; ++kb) {
        f32x16 acc;
#pragma unroll
        for (int r = 0; r < 16; ++r) acc[r] = 0.f;
#pragma unroll
        for (int s = 0; s < 4; ++s) { const bf16x8 kf = *(const LAS bf16x8*)(Kb + (32 * kb + l31) * DF_PITCH + s * 32 + hi * 16);
            acc = __builtin_amdgcn_mfma_f32_32x32x16_bf16(kf, Qf[s], acc, 0, 0, 0); }
        S[kb] = acc;
    }
    float mt = -INFINITY;
#pragma unroll
    for (int kb = 0; kb < 2; ++kb)
#pragma unroll
        for (int r = 0; r < 16; ++r) { const int j = k0 + 32 * kb + (r & 3) + 8 * (r >> 2) + 4 * hi, dist = qpos - j;
            const float bv = btab[min(max(dist, 0), 128)];
            const bool ok = (dist >= 0) && (j < NMETA || dist < 128);
            const float t = ok ? S[kb][r] + bv : -INFINITY; S[kb][r] = t; mt = fmaxf(mt, t); }
    mt *= c2;
    mt = fmaxf(mt, __shfl_xor(mt, 32));
    const float mn = fmaxf(m, mt);
    if (__any(mn > m)) { const float al = __builtin_amdgcn_exp2f(m - mn); lsum *= al; O[0] = O[0] * al; O[1] = O[1] * al; m = mn; }
    float ls = 0.f;
    bf16x8 Pf[4];
#pragma unroll
    for (int kb = 0; kb < 2; ++kb) {
#pragma unroll
        for (int r = 0; r < 16; ++r) { const float pv = __builtin_amdgcn_exp2f(S[kb][r] * c2 - mn); ls += pv; S[kb][r] = pv; }
#pragma unroll
        for (int s = 0; s < 2; ++s) Pf[2 * kb + s] = pack_acc(S[kb], s);
    }
    lsum += ls;
#pragma unroll
    for (int st = 0; st < 4; ++st) { asm volatile("" ::: "memory");
#pragma unroll
        for (int dvb = 0; dvb < 2; ++dvb) { const bf16x8 vf = *(const LAS bf16x8*)(Vb + (32 * dvb + l31) * DF_PITCH + st * 32 + hi * 16);
            O[dvb] = __builtin_amdgcn_mfma_f32_32x32x16_bf16(vf, Pf[st], O[dvb], 0, 0, 0); } }
    asm volatile("" ::: "memory");
}
__device__ __forceinline__ void ph_swa2(const Params& p, int l, LAS unsigned char* lds, const int wvid, const int qslot = 0) {
    const int bid = lt_bid(); unsigned char* const ws = lt_ptr(p.ws); (void)bid;
    const int tid = lt_tid(wvid), lane = tid & 63, wave = __builtin_amdgcn_readfirstlane(tid >> 6), l31 = lane & 31, hi = lane >> 5;
    const bf16_t* U = (const bf16_t*)(ws + WS_U); const bf16_t* VT = (const bf16_t*)(ws + WS_VTA); bf16_t* MIX = (bf16_t*)(ws + WS_MIX);
    unsigned* qhead = (unsigned*)(ws + WS_CTL) + CW_DQ + (qslot * 4 + 2 + l) * 64;
    LAS float* btab = (LAS float*)lds;
    LAS int* ucur = (LAS int*)(lds + 4 * 132 * 4);
    LAS unsigned char* KV = lds + 4096;
    constexpr float LOG2E = 1.4426950408889634f;
    __syncthreads();
    for (int i = tid; i < 4 * 129; i += NTHR) { const int h = i / 129, n = i % 129; btab[h * 132 + n] = p.in[I_RELB][t5_bucket(n) * 8 + h] * 8.0f; }
    const float c2 = 0.125f * LOG2E;
    const int krow = tid >> 3, kch = tid & 7;
    for (;;) {
        __syncthreads();
        if (tid == 0) *ucur = (int)atomicAdd(qhead, 1u);
        __syncthreads();
        const int u = *ucur;
        if (u >= 33 * 16) break;
        const int qi = 32 - u / 16, bk = u % 16, b = bk >> 1, hkv = bk & 1, hq = 2 * hkv + (wave >> 2);
        const int q0 = qi == 0 ? 0 : 16 + 128 * (qi - 1);
        const int ktlo = max(1, (q0 - 127) / 64), kthi = qi == 0 ? 0 : (q0 + 127) / 64;
        const int ntile = 1 + (kthi >= ktlo ? kthi - ktlo + 1 : 0);
        const int q0w = q0 + 32 * (wave & 3), qpos = q0w + l31;
        const bool wave_on = (qi > 0) || ((wave & 3) == 0);
        const size_t qrow = (size_t)b * LT + (qpos < LT ? qpos : LT - 1);
        bf16x8 Qf[4];
#pragma unroll
        for (int s = 0; s < 4; ++s) Qf[s] = *(const bf16x8*)(U + qrow * INW + C_QA + hq * 64 + s * 16 + hi * 8);
        f32x16 O[2]; float m = p.in[I_SINKS][l * 4 + hq] * LOG2E, lsum = hi == 0 ? 1.0f : 0.0f;
#pragma unroll
        for (int d = 0; d < 2; ++d)
#pragma unroll
            for (int r = 0; r < 16; ++r) O[d][r] = 0.f;
        const bf16_t* kbase = U + (size_t)b * LT * INW + C_KA + hkv * 64;
        const bf16_t* vbase = VT + (size_t)bk * 64 * LTP;
        const unsigned koff = (unsigned)(krow * INW + kch * 8), voff = (unsigned)(krow * LTP + kch * 8);
        u32x4 kreg = *(const u32x4*)(kbase + koff), vreg = *(const u32x4*)(vbase + voff);
        *(LAS u32x4*)(KV + krow * DF_PITCH + kch * 16) = kreg; *(LAS u32x4*)(KV + 2 * DF_KB + krow * DF_PITCH + kch * 16) = vreg;
        __syncthreads();
        for (int ti = 0; ti < ntile; ++ti) {
            const int kt = ti == 0 ? 0 : ktlo + ti - 1, k0 = kt * 64, cur = ti & 1;
            if (ti + 1 < ntile) { const int kn = (ktlo + ti) * 64; kreg = *(const u32x4*)(kbase + (koff + (unsigned)(kn * INW))); vreg = *(const u32x4*)(vbase + (voff + (unsigned)kn)); }
            if (wave_on && (kt == 0 || (k0 <= q0w + 31 && k0 + 63 >= q0w - 127)))
                swa_tile(KV + cur * DF_KB, KV + (2 + cur) * DF_KB, btab + hq * 132, Qf, O, m, lsum, qpos, k0, l31, hi, c2);
            if (ti + 1 < ntile) { *(LAS u32x4*)(KV + (cur ^ 1) * DF_KB + krow * DF_PITCH + kch * 16) = kreg; *(LAS u32x4*)(KV + (2 + (cur ^ 1)) * DF_KB + krow * DF_PITCH + kch * 16) = vreg; }
            __syncthreads();
        }
        const float lt = lsum + __shfl_xor(lsum, 32), inv = 1.0f / lt;
        const int lane2 = lt_tid(wvid) & 63, qpos2 = q0w + (lane2 & 31), hi2 = lane2 >> 5;
        if (wave_on && qpos2 < LT && (qi > 0 || qpos2 < NMETA)) {
            bf16_t* orow = MIX + ((size_t)b * LT + qpos2) * D + M_A + hq * 64;
#pragma unroll
            for (int d = 0; d < 2; ++d)
#pragma unroll
                for (int g4 = 0; g4 < 4; ++g4) { const int dv0 = 32 * d + 8 * g4 + 4 * hi2;
                    u32x2 w; w.x = pkbf(O[d][4 * g4] * inv, O[d][4 * g4 + 1] * inv); w.y = pkbf(O[d][4 * g4 + 2] * inv, O[d][4 * g4 + 3] * inv);
                    *(u32x2*)(orow + dv0) = w; }
        }
    }
    __syncthreads();
}

__device__ __forceinline__ void ph_conv2(const Params& p, int l, LAS unsigned char* lds, const int wvid) {
    const int bid = lt_bid(); unsigned char* const ws = lt_ptr(p.ws);
    const int tid = lt_tid(wvid), c = tid & 255, th = tid >> 8;
    const bf16_t* U = (const bf16_t*)(ws + WS_U); bf16_t* MIX = (bf16_t*)(ws + WS_MIX);
    LAS float* G = (LAS float*)lds;
    const float* cw = p.in[I_CONVW] + (size_t)l * 31 * 256; const float cb = p.in[I_CONVB][l * 256 + c], gg = p.in[I_GNG][l * 256 + c], gb = p.in[I_GNB][l * 256 + c];
    float wv[31];
#pragma unroll
    for (int w = 0; w < 31; ++w) wv[w] = cw[w * 256 + c];
    const bool bal = (int)gridDim.x == 256;
    const int nkk = bal ? 3 : (NB * 64 + (int)gridDim.x - 1) / (int)gridDim.x;
    for (int kk = 0; kk < nkk; ++kk) {
        int unit;
        if (!bal) unit = bid + kk * (int)gridDim.x;
        else if (kk < 2) unit = (bid >= 32 && bid < 40) ? NB * 64 : bid + 256 * kk;
        else unit = (bid >= 40 && bid < 56) ? (bid < 48 ? bid - 8 : bid + 240) : NB * 64;
        if (unit >= NB * 64) continue;
        const int b = unit >> 6, t0 = (unit & 63) * 64, ntok = (unit & 63) == 63 ? 80 : 64, nrow = ntok + 30;
        __syncthreads();
        { u32x4 av[7], gv[7];
#pragma unroll
          for (int q = 0; q < 7; ++q) { const int it = tid + q * NTHR, row = it >> 5, ch = it & 31, tt = t0 - 30 + row;
              const bf16_t* ur = U + ((size_t)b * LT + min(max(tt, 0), LT - 1)) * INW; av[q] = *(const u32x4*)(ur + C_CA + ch * 8); gv[q] = *(const u32x4*)(ur + C_CG + ch * 8);
              if (tt < 0 || tt >= LT) av[q] = (u32x4){0u, 0u, 0u, 0u}; }
#pragma unroll
          for (int q = 0; q < 7; ++q) { const int it = tid + q * NTHR, row = it >> 5, ch = it & 31;
              if (row < nrow) { float o[8];
                  const unsigned aw_[4] = {av[q].x, av[q].y, av[q].z, av[q].w}, gw_[4] = {gv[q].x, gv[q].y, gv[q].z, gv[q].w};
#pragma unroll
                  for (int e = 0; e < 4; ++e) { o[2 * e] = bflo(aw_[e]) * sigmoidf_(bflo(gw_[e])); o[2 * e + 1] = bfhi(aw_[e]) * sigmoidf_(bfhi(gw_[e])); }
                  *(LAS f32x4*)(G + row * 256 + ch * 8) = (f32x4){o[0], o[1], o[2], o[3]}; *(LAS f32x4*)(G + row * 256 + ch * 8 + 4) = (f32x4){o[4], o[5], o[6], o[7]}; } } }
        __syncthreads();
#pragma unroll 1
        for (int tb = 0; tb < (ntok >> 4); ++tb) {
            const int tl = th * (ntok >> 1) + tb * 8;
            float x[38];
#pragma unroll
            for (int i = 0; i < 38; ++i) x[i] = G[(tl + i) * 256 + c];
#pragma unroll
            for (int o = 0; o < 8; ++o) { float acc = cb;
#pragma unroll
                for (int w = 0; w < 31; ++w) acc += wv[w] * x[o + w];
                const float mean = wave_sum(acc) * (1.f / 64.f); const float dv = acc - mean; const float var = wave_sum(dv * dv) * (1.f / 64.f);
                const float y = dv * frsq(var + 1e-5f) * gg + gb;
                const int tg = t0 + tl + o;
                if (tg < LT) MIX[((size_t)b * LT + tg) * D + M_D + c] = f2bf(y * sigmoidf_(y)); }
        }
    }
    __syncthreads();
}

__device__ __forceinline__ int kperm(int k) { return (k & ~12) | ((k & 4) << 1) | ((k & 8) >> 1); }

constexpr int R1_XSP = 776, R1_XLP = 264;
__device__ __forceinline__ float scan32(float v) {
    v = dpp_add<0x111, 0xF>(v); v = dpp_add<0x112, 0xF>(v); v = dpp_add<0x114, 0xF>(v); v = dpp_add<0x118, 0xF>(v); v = dpp_add<0x142, 0xA>(v); return v;
}
__device__ __forceinline__ float fast_tanh(float x) { const float t = __expf(2.0f * x); return 1.0f - 2.0f * frcp(1.0f + t); }
__device__ __forceinline__ void ph_rwkv_prep2(const Params& p, int l, LAS unsigned char* lds, const int wvid) {
    const int bid = lt_bid(); unsigned char* const ws = lt_ptr(p.ws); unsigned char* const ob = lt_ptr((unsigned char*)p.out);
    const int wave = __builtin_amdgcn_readfirstlane(lt_tid(wvid) >> 6), h = wave >> 1, tb = wave & 1;
    const bf16_t* U = (const bf16_t*)(ws + WS_U);
    const bf16_t* LW = (const bf16_t*)(ws + WS_LORA) + (size_t)l * 65536;
    LAS bf16_t* XS = (LAS bf16_t*)lds; LAS bf16_t* XL = (LAS bf16_t*)(lds + 64 * R1_XSP * 2); LAS float* TOT = (LAS float*)(lds + 64 * R1_XSP * 2 + 64 * R1_XLP * 2);
    LAS float* PAR = TOT + 256;
    bf16_t* ATg = (bf16_t*)(ob + RO_AT); bf16_t* BTg = (bf16_t*)(ob + RO_BT); bf16_t* KTg = (bf16_t*)(ob + RO_KT); bf16_t* RTg = (bf16_t*)(ob + RO_RT); bf16_t* VVg = (bf16_t*)(ob + RO_VV);
    bf16_t* Gg = (bf16_t*)(ws + WS_RWB + RW_G); float* BCg = (float*)(ws + WS_RWB + RW_BC); float* GCg = (float*)(ws + WS_RWB + RW_GC);
    const float* mu = p.in[I_MU] + l * 1024;
    __syncthreads();
    { const int t_ = lt_tid(wvid); if (t_ < 256) { PAR[t_] = p.in[I_W0][l * 256 + t_]; PAR[256 + t_] = p.in[I_A0][l * 256 + t_]; PAR[512 + t_] = p.in[I_KK][l * 256 + t_]; PAR[768 + t_] = p.in[I_KA][l * 256 + t_]; PAR[1024 + t_] = p.in[I_RK][l * 256 + t_]; } }
    for (int unit = (bid + (int)gridDim.x - 32) % (int)gridDim.x; unit < NB * RCH; unit += gridDim.x) {
        const int b = unit / RCH, ch = unit % RCH, t0 = ch * 64;
        const int tid = lt_tid(wvid), lane = tid & 63, l31 = lane & 31, hi = lane >> 5;
        __syncthreads();
        { const int col0 = (tid & 127) * 8, trow = tid >> 7;
          const f32x4 m0 = *(const f32x4*)(mu + col0), m1 = *(const f32x4*)(mu + col0 + 4);
          u32x4 cu[17];
          const bf16_t* ub = U + (size_t)b * LT * INW + C_RW + col0;
#pragma unroll
          for (int q = 0; q < 17; ++q) { const int tg = t0 + 16 * trow + q - 1; cu[q] = *(const u32x4*)(ub + (size_t)min(max(tg, 0), LT - 1) * INW); }
#pragma unroll
          for (int q = 0; q < 17; ++q) { const int tg = t0 + 16 * trow + q - 1; const u32x4 z = (u32x4){0u, 0u, 0u, 0u}; if (tg >= LT || tg < 0) cu[q] = z; }
#pragma unroll
          for (int q = 0; q < 16; ++q) { const int t = 16 * trow + q;
              const u32x4 pq = (t0 + t >= LT) ? (u32x4){0u, 0u, 0u, 0u} : cu[q];
              const unsigned cw_[4] = {cu[q + 1].x, cu[q + 1].y, cu[q + 1].z, cu[q + 1].w}, pw_[4] = {pq.x, pq.y, pq.z, pq.w}; float x[8];
#pragma unroll
              for (int e = 0; e < 4; ++e) { const float c0 = bflo(cw_[e]), c1 = bfhi(cw_[e]); const float ml = e < 2 ? m0[2 * e] : m1[2 * e - 4], mh = e < 2 ? m0[2 * e + 1] : m1[2 * e - 3];
                  x[2 * e] = c0 + ml * (bflo(pw_[e]) - c0); x[2 * e + 1] = c1 + mh * (bfhi(pw_[e]) - c1); }
              u32x4 w; w.x = pkbf(x[0], x[1]); w.y = pkbf(x[2], x[3]); w.z = pkbf(x[4], x[5]); w.w = pkbf(x[6], x[7]);
              if (col0 < 768) *(LAS u32x4*)(XS + t * R1_XSP + col0) = w; else *(LAS u32x4*)(XL + t * R1_XLP + (col0 - 768)) = w; } }
        __syncthreads();
        { const int row = tid >> 3, sub = tid & 7;
          LAS u32x4* pw = (LAS u32x4*)(XL + row * R1_XLP + 8 * sub); LAS u32x4* pg = (LAS u32x4*)(XL + row * R1_XLP + 128 + 16 * sub);
          u32x4 w = pw[0], g0 = pg[0], g1 = pg[1];
          unsigned a_[4] = {w.x, w.y, w.z, w.w}, b_[4] = {g0.x, g0.y, g0.z, g0.w}, c_[4] = {g1.x, g1.y, g1.z, g1.w};
#pragma unroll
          for (int e = 0; e < 4; ++e) { a_[e] = pkbf(fast_tanh(bflo(a_[e])), fast_tanh(bfhi(a_[e]))); b_[e] = pkbf(sigmoidf_(bflo(b_[e])), sigmoidf_(bfhi(b_[e]))); c_[e] = pkbf(sigmoidf_(bflo(c_[e])), sigmoidf_(bfhi(c_[e]))); }
          w.x = a_[0]; w.y = a_[1]; w.z = a_[2]; w.w = a_[3]; g0.x = b_[0]; g0.y = b_[1]; g0.z = b_[2]; g0.w = b_[3]; g1.x = c_[0]; g1.y = c_[1]; g1.z = c_[2]; g1.w = c_[3];
          pw[0] = w; pg[0] = g0; pg[1] = g1; }
        __syncthreads();
        f32x16 aw[2], aa[2], ag[2];
#pragma unroll
        for (int cb = 0; cb < 2; ++cb)
#pragma unroll
            for (int r = 0; r < 16; ++r) { aw[cb][r] = 0.f; aa[cb][r] = 0.f; ag[cb][r] = 0.f; }
        const LAS bf16_t* xrow = XL + (32 * tb + l31) * R1_XLP + 8 * hi;
        {
            bf16x8 wf[4][2], af[4][2];
#pragma unroll
            for (int ks = 0; ks < 4; ++ks)
#pragma unroll
                for (int cb = 0; cb < 2; ++cb) { const int c = 64 * h + 32 * cb + l31; wf[ks][cb] = *(const bf16x8*)(LW + c * 64 + 16 * ks + 8 * hi); af[ks][cb] = *(const bf16x8*)(LW + 16384 + c * 64 + 16 * ks + 8 * hi); }
            asm volatile("" ::: "memory");
#pragma unroll
            for (int ks = 0; ks < 4; ++ks) { const bf16x8 fw = *(const LAS bf16x8*)(xrow + 16 * ks), fa = *(const LAS bf16x8*)(xrow + 64 + 16 * ks);
#pragma unroll
                for (int cb = 0; cb < 2; ++cb) { aw[cb] = __builtin_amdgcn_mfma_f32_32x32x16_bf16(wf[ks][cb], fw, aw[cb], 0, 0, 0); aa[cb] = __builtin_amdgcn_mfma_f32_32x32x16_bf16(af[ks][cb], fa, aa[cb], 0, 0, 0); } }
        }
        {
            bf16x8 gf[8][2];
#pragma unroll
            for (int ks = 0; ks < 8; ++ks)
#pragma unroll
                for (int cb = 0; cb < 2; ++cb) { const int c = 64 * h + 32 * cb + l31; gf[ks][cb] = *(const bf16x8*)(LW + 32768 + c * 128 + 16 * ks + 8 * hi); }
            asm volatile("" ::: "memory");
#pragma unroll
            for (int ks = 0; ks < 8; ++ks) { const bf16x8 fg = *(const LAS bf16x8*)(xrow + 128 + 16 * ks);
#pragma unroll
                for (int cb = 0; cb < 2; ++cb) ag[cb] = __builtin_amdgcn_mfma_f32_32x32x16_bf16(gf[ks][cb], fg, ag[cb], 0, 0, 0); }
        }
        const int t = 32 * tb + l31, tg = t0 + t; const bool ok = tg < LT; const size_t row = (size_t)b * LT + (ok ? tg : LT - 1);
        if (ok) {
#pragma unroll
            for (int cb = 0; cb < 2; ++cb)
#pragma unroll
                for (int q = 0; q < 4; ++q) { u32x2 w; w.x = pkbf(ag[cb][4 * q], ag[cb][4 * q + 1]); w.y = pkbf(ag[cb][4 * q + 2], ag[cb][4 * q + 3]);
                    *(u32x2*)(Gg + row * 256 + 64 * h + 32 * cb + 8 * q + 4 * hi) = w; } }
        float cum[2][16];
#pragma unroll
        for (int cb = 0; cb < 2; ++cb)
#pragma unroll
            for (int q = 0; q < 4; ++q) { const int c0 = 64 * h + 32 * cb + 8 * q + 4 * hi; const f32x4 w0 = *(const LAS f32x4*)(PAR + c0), a0 = *(const LAS f32x4*)(PAR + 256 + c0);
#pragma unroll
                for (int i = 0; i < 4; ++i) { const int r = 4 * q + i; const float lw = ok ? -0.6065306597126334f * sigmoidf_(w0[i] + aw[cb][r]) : 0.f; aw[cb][r] = lw; cum[cb][r] = scan32(lw);
                    aa[cb][r] = sigmoidf_(a0[i] + aa[cb][r]); } }
        if (tb == 0 && l31 == 31) {
#pragma unroll
            for (int cb = 0; cb < 2; ++cb)
#pragma unroll
                for (int q = 0; q < 4; ++q) *(LAS f32x4*)(TOT + 64 * h + 32 * cb + 8 * q + 4 * hi) = (f32x4){cum[cb][4 * q], cum[cb][4 * q + 1], cum[cb][4 * q + 2], cum[cb][4 * q + 3]}; }
        __syncthreads();
        if (tb == 1) {
#pragma unroll
            for (int cb = 0; cb < 2; ++cb)
#pragma unroll
                for (int q = 0; q < 4; ++q) { const f32x4 t0s = *(const LAS f32x4*)(TOT + 64 * h + 32 * cb + 8 * q + 4 * hi);
#pragma unroll
                    for (int i = 0; i < 4; ++i) cum[cb][4 * q + i] += t0s[i];
                    if (l31 == 31) *(f32x4*)(GCg + ((size_t)(b * 4 + h) * RCH + ch) * 64 + 32 * cb + 8 * q + 4 * hi) =
                        (f32x4){__expf(cum[cb][4 * q]), __expf(cum[cb][4 * q + 1]), __expf(cum[cb][4 * q + 2]), __expf(cum[cb][4 * q + 3])}; } }
        const LAS bf16_t* xs = XS + t * R1_XSP + 64 * h + 4 * hi;
        float n2 = 0.f, bc = 0.f;
#pragma unroll
        for (int cb = 0; cb < 2; ++cb)
#pragma unroll
            for (int q = 0; q < 4; ++q) { const int c0 = 64 * h + 32 * cb + 8 * q + 4 * hi; const int xo = 32 * cb + 8 * q;
                const u32x2 r2 = *(const LAS u32x2*)(xs + xo), k2 = *(const LAS u32x2*)(xs + 256 + xo);
                const f32x4 kkp = *(const LAS f32x4*)(PAR + 512 + c0), kap = *(const LAS f32x4*)(PAR + 768 + c0), rk = *(const LAS f32x4*)(PAR + 1024 + c0);
                const float rr[4] = {bflo(r2.x), bfhi(r2.x), bflo(r2.y), bfhi(r2.y)}, kr[4] = {bflo(k2.x), bfhi(k2.x), bflo(k2.y), bfhi(k2.y)};
#pragma unroll
                for (int i = 0; i < 4; ++i) { const float kkr = kr[i] * kkp[i], km = kr[i] * (1.0f + (aa[cb][4 * q + i] - 1.0f) * kap[i]); n2 += kkr * kkr; bc += rr[i] * km * rk[i]; } }
        n2 += __shfl_xor(n2, 32); bc += __shfl_xor(bc, 32);
        if (ok && hi == 0) BCg[row * 4 + h] = bc;
        const float rn = frsq(fmaxf(n2, 1e-24f));
        const size_t obase = ((size_t)(b * 4 + h) * RCH + ch) * 4096 + (size_t)t * 64 + 4 * hi;
#pragma unroll
        for (int cb = 0; cb < 2; ++cb)
#pragma unroll
            for (int q = 0; q < 4; ++q) { const int c0 = 64 * h + 32 * cb + 8 * q + 4 * hi; const int xo = 32 * cb + 8 * q;
                const u32x2 r2 = *(const LAS u32x2*)(xs + xo), k2 = *(const LAS u32x2*)(xs + 256 + xo), v2 = *(const LAS u32x2*)(xs + 512 + xo);
                const f32x4 kkp = *(const LAS f32x4*)(PAR + 512 + c0), kap = *(const LAS f32x4*)(PAR + 768 + c0);
                const float rr[4] = {bflo(r2.x), bfhi(r2.x), bflo(r2.y), bfhi(r2.y)}, kr[4] = {bflo(k2.x), bfhi(k2.x), bflo(k2.y), bfhi(k2.y)};
                float oa[4], obb[4], ok_[4], orr[4];
#pragma unroll
                for (int i = 0; i < 4; ++i) { const int r = 4 * q + i; const float a = aa[cb][r], kk = kr[i] * kkp[i] * rn, km = kr[i] * (1.0f + (a - 1.0f) * kap[i]);
                    const float gam = __expf(cum[cb][r]), gprev = __expf(cum[cb][r] - aw[cb][r]), ig = __expf(-cum[cb][r]);
                    oa[i] = ok ? -gprev * kk : 0.f; obb[i] = ok ? kk * a * ig : 0.f; ok_[i] = ok ? km * ig : 0.f; orr[i] = ok ? gam * rr[i] : 0.f; }
                const size_t o = obase + xo;
#define PST(ptr, val) do { *(u32x2*)(ptr) = (val); if (PROBE_DUP == 22) { asm volatile("" ::: "memory"); *(u32x2*)(ptr) = (val); asm volatile("" ::: "memory"); *(u32x2*)(ptr) = (val); asm volatile("" ::: "memory"); } } while (0)
                u32x2 w; w.x = pkbf(oa[0], oa[1]); w.y = pkbf(oa[2], oa[3]); PST(ATg + o, w);
                w.x = pkbf(obb[0], obb[1]); w.y = pkbf(obb[2], obb[3]); PST(BTg + o, w);
                w.x = pkbf(ok_[0], ok_[1]); w.y = pkbf(ok_[2], ok_[3]); PST(KTg + o, w);
                w.x = pkbf(orr[0], orr[1]); w.y = pkbf(orr[2], orr[3]); PST(RTg + o, w);
                const u32x2 vz = ok ? v2 : (u32x2){0u, 0u}; PST(VVg + o, vz); }
    }
    __syncthreads();
}

constexpr int R2_P = 144, R2_MB = 64 * R2_P;
typedef f32x16 M64[2][2];
#define R2_ZERO(M) do { _Pragma("unroll") for (int _a = 0; _a < 2; ++_a) _Pragma("unroll") for (int _b = 0; _b < 2; ++_b) _Pragma("unroll") for (int _r = 0; _r < 16; ++_r) M[_a][_b][_r] = 0.f; } while (0)
#define R2_MM_GG(M, Lg, Rg) do { bf16x8 _a[4][2], _b[4][2];     \
        _Pragma("unroll") for (int _ks = 0; _ks < 4; ++_ks) _Pragma("unroll") for (int _x = 0; _x < 2; ++_x) { \
            _a[_ks][_x] = *(const bf16x8*)((Lg) + (32 * _x + l31) * 64 + 16 * _ks + 8 * hi); _b[_ks][_x] = *(const bf16x8*)((Rg) + (32 * _x + l31) * 64 + 16 * _ks + 8 * hi); } \
        asm volatile("" ::: "memory"); \
        _Pragma("unroll") for (int _ks = 0; _ks < 4; ++_ks) _Pragma("unroll") for (int _rb = 0; _rb < 2; ++_rb) _Pragma("unroll") for (int _cb = 0; _cb < 2; ++_cb) \
            M[_rb][_cb] = __builtin_amdgcn_mfma_f32_32x32x16_bf16(_a[_ks][_rb], _b[_ks][_cb], M[_rb][_cb], 0, 0, 0); } while (0)
#define R2_MM_LP(M, buf, Bpk) do { asm volatile("" ::: "memory"); _Pragma("unroll") for (int _ks = 0; _ks < 4; ++_ks) _Pragma("unroll") for (int _rb = 0; _rb < 2; ++_rb) { \
        const bf16x8 _a = *(const LAS bf16x8*)((buf) + (32 * _rb + l31) * R2_P + (16 * _ks + 8 * hi) * 2); \
        _Pragma("unroll") for (int _cb = 0; _cb < 2; ++_cb) M[_rb][_cb] = __builtin_amdgcn_mfma_f32_32x32x16_bf16(_a, Bpk[_ks][_cb], M[_rb][_cb], 0, 0, 0); } } while (0)
#define R2_PACK(Bpk, M) do { _Pragma("unroll") for (int _ks = 0; _ks < 4; ++_ks) _Pragma("unroll") for (int _cb = 0; _cb < 2; ++_cb) Bpk[_ks][_cb] = pack_acc(M[_ks >> 1][_cb], _ks & 1); } while (0)
#define R2_TO_LDS(buf, M) do { asm volatile("" ::: "memory"); _Pragma("unroll") for (int _rb = 0; _rb < 2; ++_rb) _Pragma("unroll") for (int _cb = 0; _cb < 2; ++_cb) _Pragma("unroll") for (int _r = 0; _r < 16; _r += 2) { \
        const unsigned _w = pkbf(M[_rb][_cb][_r], M[_rb][_cb][_r + 1]); LAS unsigned char* _a = (buf) + (32 * _rb + (_r & 3) + 8 * (_r >> 2) + 4 * hi) * R2_P + kperm(32 * _cb + l31) * 2; \
        *(LAS bf16_t*)_a = (bf16_t)_w; *(LAS bf16_t*)(_a + R2_P) = (bf16_t)(_w >> 16); } asm volatile("" ::: "memory"); } while (0)
#define R2_MASK(M, STRICT) do { _Pragma("unroll") for (int _rb = 0; _rb < 2; ++_rb) _Pragma("unroll") for (int _cb = 0; _cb < 2; ++_cb) _Pragma("unroll") for (int _r = 0; _r < 16; ++_r) { \
        const int _row = 32 * _rb + (_r & 3) + 8 * (_r >> 2) + 4 * hi, _col = 32 * _cb + l31; if (STRICT ? !(_row < _col) : !(_row <= _col)) M[_rb][_cb][_r] = 0.f; } } while (0)
#define R2_PSEUDO(Bpk, Xg) do { _Pragma("unroll") for (int _ks = 0; _ks < 4; ++_ks) _Pragma("unroll") for (int _cb = 0; _cb < 2; ++_cb) { unsigned _w[4]; \
        _Pragma("unroll") for (int _e = 0; _e < 8; _e += 2) { const int _t = 16 * _ks + 8 * (_e >> 2) + 4 * hi + (_e & 3); \
            _w[_e >> 1] = (unsigned)(Xg)[_t * 64 + 32 * _cb + l31] | ((unsigned)(Xg)[(_t + 1) * 64 + 32 * _cb + l31] << 16); } \
        u32x4 _v; _v.x = _w[0]; _v.y = _w[1]; _v.z = _w[2]; _v.w = _w[3]; Bpk[_ks][_cb] = __builtin_bit_cast(bf16x8, _v); } } while (0)
#define R2_TRANS(buf, Xg) do { asm volatile("" ::: "memory"); _Pragma("unroll") for (int _q = 0; _q < 8; ++_q) { unsigned _w[4]; \
        _Pragma("unroll") for (int _e = 0; _e < 8; _e += 2) _w[_e >> 1] = (unsigned)(Xg)[kperm(8 * _q + _e) * 64 + lane] | ((unsigned)(Xg)[kperm(8 * _q + _e + 1) * 64 + lane] << 16); \
        u32x4 _v; _v.x = _w[0]; _v.y = _w[1]; _v.z = _w[2]; _v.w = _w[3]; *(LAS u32x4*)((buf) + lane * R2_P + _q * 16) = _v; } asm volatile("" ::: "memory"); } while (0)
#define R2_STORE_T(dst, M, PERM, SC) do { _Pragma("unroll") for (int _rb = 0; _rb < 2; ++_rb) _Pragma("unroll") for (int _cb = 0; _cb < 2; ++_cb) _Pragma("unroll") for (int _q = 0; _q < 4; ++_q) { \
        const int _row0 = 32 * _rb + 8 * _q + 4 * hi; u32x2 _w; _w.x = pkbf(M[_rb][_cb][4 * _q] * (SC), M[_rb][_cb][4 * _q + 1] * (SC)); _w.y = pkbf(M[_rb][_cb][4 * _q + 2] * (SC), M[_rb][_cb][4 * _q + 3] * (SC)); \
        *(u32x2*)((dst) + (32 * _cb + l31) * 64 + ((PERM) ? kperm(_row0) : _row0)) = _w; } } while (0)

__device__ __forceinline__ void ph_rwkv_chunk(const Params& p, int l, LAS unsigned char* lds, const int wvid) {
    const int bid = lt_bid(); unsigned char* const ws = lt_ptr(p.ws); unsigned char* const ob = lt_ptr((unsigned char*)p.out);
    const int wave = __builtin_amdgcn_readfirstlane(lt_tid(wvid) >> 6);
    LAS unsigned char* X = lds + wave * (2 * R2_MB); LAS unsigned char* Y = X + R2_MB;
    for (int rnd = 0; rnd < 2; ++rnd) {
        const int unit = rnd == 0 ? bid * NWAVE + wave : (((bid & 7) == 0 && wave == 0) ? (int)gridDim.x * NWAVE + (bid >> 3) : RUN);
        if (unit >= RUN) continue;
        int lane = lt_tid(wvid) & 63, l31 = lane & 31, hi = lane >> 5;
#define R2_RELANE() do { lane = lt_tid(wvid) & 63; l31 = lane & 31; hi = lane >> 5; } while (0)
        const size_t uo = (size_t)unit * 4096;
        const bf16_t* ATg = (const bf16_t*)(ob + RO_AT) + uo; const bf16_t* BTg = (const bf16_t*)(ob + RO_BT) + uo; const bf16_t* KTg = (const bf16_t*)(ob + RO_KT) + uo;
        const bf16_t* RTg = (const bf16_t*)(ob + RO_RT) + uo; const bf16_t* VVg = (const bf16_t*)(ob + RO_VV) + uo;
        bf16_t* PTg = (bf16_t*)(ob + RO_PT) + uo; bf16_t* QTg = (bf16_t*)(ob + RO_QT) + uo; bf16_t* GTg = (bf16_t*)(ws + WS_RWB + RW_GT) + uo; bf16_t* YLg = (bf16_t*)(ws + WS_RWB + RW_YL) + uo;
        const float gc0 = ((const float*)(ws + WS_RWB + RW_GC))[(size_t)unit * 64 + l31], gc1 = ((const float*)(ws + WS_RWB + RW_GC))[(size_t)unit * 64 + 32 + l31];
        bf16x8 Tpk[4][2], ABR[4][2];
        {
            M64 A; R2_ZERO(A); R2_MM_GG(A, BTg, ATg); R2_MASK(A, true);
            M64 Tm;
#pragma unroll
            for (int rb = 0; rb < 2; ++rb)
#pragma unroll
                for (int cb = 0; cb < 2; ++cb)
#pragma unroll
                    for (int r = 0; r < 16; ++r) Tm[rb][cb][r] = A[rb][cb][r] + ((rb == cb && ((r & 3) + 8 * (r >> 2) + 4 * hi) == l31) ? 1.f : 0.f);
            bf16x8 Apk[4][2];
            R2_TO_LDS(X, A); R2_PACK(Apk, A);
#pragma unroll 1
            for (int it = 0; it < 5; ++it) {
                { M64 A2; R2_ZERO(A2); R2_MM_LP(A2, X, Apk);
                  asm volatile("" ::: "memory");
                  R2_TO_LDS(X, A2); R2_PACK(Apk, A2); }
                R2_PACK(Tpk, Tm);
                R2_MM_LP(Tm, X, Tpk);
                asm volatile("" ::: "memory");
            }
            R2_PACK(Tpk, Tm);
        }
        {
            R2_TRANS(Y, ATg);
            M64 W; R2_ZERO(W); R2_MM_LP(W, Y, Tpk);
            R2_TO_LDS(X, W);
        }
        R2_RELANE();
        {
            M64 B; R2_ZERO(B); R2_MM_GG(B, BTg, RTg); R2_MASK(B, false); R2_PACK(ABR, B);
        }
        {
            M64 G;
#pragma unroll
            for (int rb = 0; rb < 2; ++rb)
#pragma unroll
                for (int cb = 0; cb < 2; ++cb)
#pragma unroll
                    for (int q = 0; q < 4; ++q) { const u32x2 w = *(const u32x2*)(RTg + (32 * cb + l31) * 64 + 32 * rb + 8 * q + 4 * hi);
                        G[rb][cb][4 * q] = bflo(w.x); G[rb][cb][4 * q + 1] = bfhi(w.x); G[rb][cb][4 * q + 2] = bflo(w.y); G[rb][cb][4 * q + 3] = bfhi(w.y); }
            R2_MM_LP(G, X, ABR);
            R2_STORE_T(GTg, G, true, 1.0f);
        }
        {
            bf16x8 Bp[4][2]; R2_PSEUDO(Bp, BTg);
            M64 P; R2_ZERO(P); R2_MM_LP(P, X, Bp);
#pragma unroll
            for (int rb = 0; rb < 2; ++rb)
#pragma unroll
                for (int r = 0; r < 16; ++r) if (((r & 3) + 8 * (r >> 2) + 4 * hi) == l31) P[rb][rb][r] += 1.f;
#pragma unroll
            for (int rb = 0; rb < 2; ++rb)
#pragma unroll
                for (int r = 0; r < 16; ++r) { P[rb][0][r] *= gc0; P[rb][1][r] *= gc1; }
            R2_STORE_T(PTg, P, true, 1.0f);
        }
        R2_RELANE();
        bf16x8 Zpk[4][2];
        {
            M64 A; R2_ZERO(A); R2_MM_GG(A, KTg, ATg); R2_MASK(A, true);
            asm volatile("" ::: "memory");
            R2_TO_LDS(X, A);
            M64 Z; R2_ZERO(Z); R2_MM_LP(Z, X, Tpk); R2_PACK(Zpk, Z);
        }
        {
            R2_TRANS(Y, VVg);
            M64 W; R2_ZERO(W); R2_MM_LP(W, Y, Zpk);
            asm volatile("" ::: "memory");
            R2_TO_LDS(X, W);
        }
        R2_RELANE();
        {
            bf16x8 AKR[4][2];
            { M64 B; R2_ZERO(B); R2_MM_GG(B, KTg, RTg); R2_MASK(B, false); R2_PACK(AKR, B); }
            M64 Yl; R2_ZERO(Yl); R2_MM_LP(Yl, X, ABR); R2_MM_LP(Yl, Y, AKR);
            R2_STORE_T(YLg, Yl, false, 1.0f);
        }
        R2_RELANE();
        {
            M64 Q; R2_ZERO(Q);
            { bf16x8 Bp[4][2]; R2_PSEUDO(Bp, BTg); R2_MM_LP(Q, X, Bp); }
            { bf16x8 Kp[4][2]; R2_PSEUDO(Kp, KTg); R2_MM_LP(Q, Y, Kp); }
#pragma unroll
            for (int rb = 0; rb < 2; ++rb)
#pragma unroll
                for (int r = 0; r < 16; ++r) { Q[rb][0][r] *= gc0; Q[rb][1][r] *= gc1; }
            R2_STORE_T(QTg, Q, false, 1.0f);
        }
        asm volatile("" ::: "memory");
    }
    if (l == 0) tr_in_rwkv_idle<6>(p, ws, lds, bid, wvid);
    asm volatile("s_waitcnt vmcnt(0)" ::: "memory");
    __syncthreads();
    if (lt_tid(wvid) == 0) { __builtin_amdgcn_fence(__ATOMIC_RELEASE, "agent"); asm volatile("s_waitcnt vmcnt(0)" ::: "memory");
        __hip_atomic_fetch_add((unsigned*)(ws + WS_CTL) + CW_R2D + l * 64, 1u, __ATOMIC_RELAXED, __HIP_MEMORY_SCOPE_AGENT); }
}

__device__ __forceinline__ void ph_rwkv_scan2(const Params& p, int l, LAS unsigned char* lds, int first_block, const int wvid) {
    const int bid = lt_bid(); unsigned char* const ob = lt_ptr((unsigned char*)p.out);
    const int tid = lt_tid(wvid), lane = tid & 63, wave = __builtin_amdgcn_readfirstlane(tid >> 6), l31 = lane & 31, hi = lane >> 5;
    const int sw = (bid - first_block) * 4 + wave;
    if (bid < first_block) return;
    {
        if (tid == 0) { unsigned* r2d = (unsigned*)(lt_ptr(p.ws) + WS_CTL) + CW_R2D + l * 64; unsigned sp = 0;
            while (__hip_atomic_load(r2d, __ATOMIC_RELAXED, __HIP_MEMORY_SCOPE_AGENT) < gridDim.x) { __builtin_amdgcn_s_sleep(2); if (++sp > (1u << 24)) break; }
            __builtin_amdgcn_fence(__ATOMIC_ACQUIRE, "agent"); asm volatile("s_waitcnt vmcnt(0)" ::: "memory"); }
        __syncthreads();
    }
    if (wave >= 4 || sw >= 64) return;
    const int bh = sw >> 1, ib = sw & 1;
    const bf16_t* PT = (const bf16_t*)(ob + RO_PT) + (size_t)bh * RCH * 4096; const bf16_t* QT = (const bf16_t*)(ob + RO_QT) + (size_t)bh * RCH * 4096;
    u32x4* SH = (u32x4*)(ob + RO_SH) + (size_t)bh * RCH * 512;
    bf16x8 Sp[4];
    { unsigned z; asm volatile("v_mov_b32 %0, 0" : "=v"(z));
#pragma unroll
      for (int ks = 0; ks < 4; ++ks) { u32x4 zz; zz.x = z; zz.y = z; zz.z = z; zz.w = z; Sp[ks] = __builtin_bit_cast(bf16x8, zz); } }
    bf16x8 Pf[2][4]; unsigned short Qi[2][16];
#define R3_LOAD(c) do { const bf16_t* _p = PT + (size_t)(c) * 4096; const bf16_t* _q = QT + (size_t)(c) * 4096; \
        _Pragma("unroll") for (int _jb = 0; _jb < 2; ++_jb) { _Pragma("unroll") for (int _ks = 0; _ks < 4; ++_ks) Pf[_jb][_ks] = *(const bf16x8*)(_p + (32 * _jb + l31) * 64 + 16 * _ks + 8 * hi); \
            _Pragma("unroll") for (int _r = 0; _r < 16; ++_r) Qi[_jb][_r] = _q[(32 * _jb + (_r & 3) + 8 * (_r >> 2) + 4 * hi) * 64 + 32 * ib + l31]; } } while (0)
    R3_LOAD(0);
    for (int c = 0; c < RCH; ++c) {
#pragma unroll
        for (int ks = 0; ks < 4; ++ks) SH[(size_t)c * 512 + (ib * 4 + ks) * 64 + lane] = __builtin_bit_cast(u32x4, Sp[ks]);
        if (c + 1 == RCH) break;
        f32x16 acc[2];
#pragma unroll
        for (int jb = 0; jb < 2; ++jb)
#pragma unroll
            for (int r = 0; r < 16; ++r) acc[jb][r] = bf2f(Qi[jb][r]);
        bf16x8 Pc[2][4];
#pragma unroll
        for (int jb = 0; jb < 2; ++jb)
#pragma unroll
            for (int ks = 0; ks < 4; ++ks) Pc[jb][ks] = Pf[jb][ks];
        if (c + 2 < RCH) R3_LOAD(c + 1);
#pragma unroll
        for (int ks = 0; ks < 4; ++ks)
#pragma unroll
            for (int jb = 0; jb < 2; ++jb) acc[jb] = __builtin_amdgcn_mfma_f32_32x32x16_bf16(Pc[jb][ks], Sp[ks], acc[jb], 0, 0, 0);
#pragma unroll
        for (int ks = 0; ks < 4; ++ks) Sp[ks] = pack_acc(acc[ks >> 1], ks & 1);
    }
#undef R3_LOAD
}

__device__ __forceinline__ void ph_rwkv_out(const Params& p, int l, LAS unsigned char* lds, const int wvid) {
    const int bid = lt_bid(); unsigned char* const ws = lt_ptr(p.ws); unsigned char* const ob = lt_ptr((unsigned char*)p.out);
    const int wave = __builtin_amdgcn_readfirstlane(lt_tid(wvid) >> 6);
    bf16_t* MIX = (bf16_t*)(ws + WS_MIX);
    const bf16_t* Gg = (const bf16_t*)(ws + WS_RWB + RW_G); const float* BCg = (const float*)(ws + WS_RWB + RW_BC);
    for (int rnd = 0; rnd < 2; ++rnd) {
        const int unit = rnd == 0 ? bid * NWAVE + wave : (((bid & 7) == 0 && wave == 0) ? (int)gridDim.x * NWAVE + (bid >> 3) : RUN);
        if (unit >= RUN) continue;
        const int lane = lt_tid(wvid) & 63, l31 = lane & 31, hi = lane >> 5;
        const int bh = unit / RCH, ch = unit % RCH, b = bh >> 2, h = bh & 3, t0 = ch * 64;
        const size_t uo = (size_t)unit * 4096;
        const bf16_t* GTg = (const bf16_t*)(ws + WS_RWB + RW_GT) + uo; const bf16_t* YLg = (const bf16_t*)(ws + WS_RWB + RW_YL) + uo; const bf16_t* VVg = (const bf16_t*)(ob + RO_VV) + uo;
        const u32x4* SH = (const u32x4*)(ob + RO_SH) + (size_t)unit * 512;
        bf16x8 ga[4][2], sb[4][2]; unsigned short yl[2][2][16];
#pragma unroll
        for (int ks = 0; ks < 4; ++ks)
#pragma unroll
            for (int x = 0; x < 2; ++x) { ga[ks][x] = *(const bf16x8*)(GTg + (32 * x + l31) * 64 + 16 * ks + 8 * hi); sb[ks][x] = __builtin_bit_cast(bf16x8, SH[(x * 4 + ks) * 64 + lane]); }
#pragma unroll
        for (int rb = 0; rb < 2; ++rb)
#pragma unroll
            for (int cb = 0; cb < 2; ++cb)
#pragma unroll
                for (int r = 0; r < 16; ++r) yl[rb][cb][r] = YLg[(32 * rb + (r & 3) + 8 * (r >> 2) + 4 * hi) * 64 + 32 * cb + l31];
        M64 Yt;
#pragma unroll
        for (int rb = 0; rb < 2; ++rb)
#pragma unroll
            for (int cb = 0; cb < 2; ++cb)
#pragma unroll
                for (int r = 0; r < 16; ++r) Yt[rb][cb][r] = bf2f(yl[rb][cb][r]);
#pragma unroll
        for (int ks = 0; ks < 4; ++ks)
#pragma unroll
            for (int rb = 0; rb < 2; ++rb)
#pragma unroll
                for (int cb = 0; cb < 2; ++cb) Yt[rb][cb] = __builtin_amdgcn_mfma_f32_32x32x16_bf16(ga[ks][rb], sb[ks][cb], Yt[rb][cb], 0, 0, 0);
        const float lg0 = p.in[I_LNXG][l * 256 + h * 64 + l31], lg1 = p.in[I_LNXG][l * 256 + h * 64 + 32 + l31], lb0 = p.in[I_LNXB][l * 256 + h * 64 + l31], lb1 = p.in[I_LNXB][l * 256 + h * 64 + 32 + l31];
#pragma unroll
        for (int rb = 0; rb < 2; ++rb) {
            unsigned short v0[16], v1[16], g0[16], g1[16]; float bcv[16];
#pragma unroll
            for (int r = 0; r < 16; ++r) { const int t = 32 * rb + (r & 3) + 8 * (r >> 2) + 4 * hi; const int tg = min(t0 + t, LT - 1); const size_t row = (size_t)b * LT + tg;
                v0[r] = VVg[t * 64 + l31]; v1[r] = VVg[t * 64 + 32 + l31]; g0[r] = Gg[row * 256 + h * 64 + l31]; g1[r] = Gg[row * 256 + h * 64 + 32 + l31]; bcv[r] = BCg[row * 4 + h]; }
#pragma unroll
            for (int r = 0; r < 16; ++r) { const int t = 32 * rb + (r & 3) + 8 * (r >> 2) + 4 * hi, tg = t0 + t;
                const float y0 = Yt[rb][0][r], y1 = Yt[rb][1][r];
                const float mean = half_sum32(y0 + y1) * (1.f / 64.f); const float d0 = y0 - mean, d1 = y1 - mean;
                const float var = half_sum32(d0 * d0 + d1 * d1) * (1.f / 64.f); const float rs = frsq(var + 64e-5f);
                if (tg < LT) { const size_t row = (size_t)b * LT + tg;
                    const float o0 = (d0 * rs * lg0 + lb0 + bcv[r] * bf2f(v0[r])) * bf2f(g0[r]);
                    const float o1 = (d1 * rs * lg1 + lb1 + bcv[r] * bf2f(v1[r])) * bf2f(g1[r]);
                    MIX[row * D + M_C + h * 64 + l31] = f2bf(o0); MIX[row * D + M_C + h * 64 + 32 + l31] = f2bf(o1); } }
        }
    }
    if (l == 0) tr_in_rwkv_idle<7>(p, ws, lds, bid, wvid);
    __syncthreads();
}

__device__ __forceinline__ void ph_ln1(const Params& p, int l, LAS unsigned char* lds, const int wvid) {
    const int bid = lt_bid(); unsigned char* const ws = lt_ptr(p.ws); (void)bid; (void)ws;
    const int tid = lt_tid(wvid), lane = tid & 63, wave = tid >> 6, gw = bid * NWAVE + wave, NGW = gridDim.x * NWAVE;
    LAS float* rw = (LAS float*)lds;
    LAS float* LG = (LAS float*)(lds + 69632);
    LAS int* lcnt = (LAS int*)(lds + 65536); LAS int* lbase = lcnt + 16; LAS int* ent = lcnt + 32;
    __syncthreads();
    for (int i = tid; i < D * NE / 4; i += NTHR) { const f32x4 w = *(const f32x4*)(p.in[I_ROUTW] + 4 * i); const int c = i >> 2, e0 = (i & 3) * 4;
        rw[(e0 + 0) * D + c] = w[0]; rw[(e0 + 1) * D + c] = w[1]; rw[(e0 + 2) * D + c] = w[2]; rw[(e0 + 3) * D + c] = w[3]; }
    if (tid < 16) lcnt[tid] = 0;
    __syncthreads();
    const bf16_t* Z = (const bf16_t*)(ws + WS_Z); bf16_t* HB = (bf16_t*)(ws + WS_HB);
    unsigned* cnt = (unsigned*)(ws + WS_CTL) + CW_CNT + l * 16;
    int* TE = (int*)(ws + WS_TOKE); int* TP = (int*)(ws + WS_TOKP);
    const LnPar ln1 = ln_par(p.in[I_LN1G] + l * D, p.in[I_LN1B] + l * D, lane);
    int k = 0;
    u32x2 zn[4];
#pragma unroll
    for (int j = 0; j < 4; ++j) zn[j] = *(const u32x2*)(Z + (size_t)min(gw, T - 1) * D + 4 * lane + 256 * j);
    for (int r = gw; r < T; r += NGW, ++k) {
        f32x4 v[4]; u32x2 zc[4];
#pragma unroll
        for (int j = 0; j < 4; ++j) { zc[j] = zn[j]; zn[j] = *(const u32x2*)(Z + (size_t)min(r + NGW, T - 1) * D + 4 * lane + 256 * j); }
        if (r < MP - 256) {
#pragma unroll
            for (int j = 0; j < 4; ++j) { const u32x2 z = zc[j]; v[j] = (f32x4){bflo(z.x), bfhi(z.x), bflo(z.y), bfhi(z.y)}; }
        } else {
            const float* zp = (const float*)(ws + WS_ZP) + (size_t)(r - (MP - 256)) * D + 4 * lane;
#pragma unroll
            for (int j = 0; j < 4; ++j) { const u32x2 hh = *(const u32x2*)(HB + (size_t)r * D + 4 * lane + 256 * j); f32x4 a = (f32x4){ALPHA * bflo(hh.x), ALPHA * bfhi(hh.x), ALPHA * bflo(hh.y), ALPHA * bfhi(hh.y)};
#pragma unroll
                for (int k2 = 0; k2 < ZSPLIT; ++k2) a = a + *(const f32x4*)(zp + (size_t)k2 * 256 * D + 256 * j);
                v[j] = a; }
        }
        ln_affine(v, ln1);
        store_row_bf16(HB + (size_t)r * D, v, lane);
        float lg[16];
#pragma unroll
        for (int e = 0; e < 16; ++e) lg[e] = 0.f;
#pragma unroll
        for (int j = 0; j < 4; ++j)
#pragma unroll
            for (int e = 0; e < 16; ++e) { const f32x4 w = *(const LAS f32x4*)(rw + e * D + 256 * j + 4 * lane);
                lg[e] += (v[j][0] * w[0] + v[j][1] * w[1]) + (v[j][2] * w[2] + v[j][3] * w[3]); }
        { const bool b3 = lane & 8, b2 = lane & 4, b1 = lane & 2, b0 = lane & 1;
          float h8[8], h4[4], h2[2];
#pragma unroll
          for (int i = 0; i < 8; ++i) h8[i] = (b3 ? lg[i + 8] : lg[i]) + dpp_get<0x128>(b3 ? lg[i] : lg[i + 8]);
#pragma unroll
          for (int i = 0; i < 4; ++i) h4[i] = (b2 ? h8[i + 4] : h8[i]) + dpp_get<0x141>(b2 ? h8[i] : h8[i + 4]);
#pragma unroll
          for (int i = 0; i < 2; ++i) h2[i] = (b1 ? h4[i + 2] : h4[i]) + dpp_get<0x4E>(b1 ? h4[i] : h4[i + 2]);
          float x = (b0 ? h2[1] : h2[0]) + dpp_get<0xB1>(b0 ? h2[0] : h2[1]);
          x += __shfl_xor(x, 16); x += __shfl_xor(x, 32);
          if (lane < 16) LG[(wave * 20 + k) * 16 + lane] = x; }
    }
    float gt1 = 0.f, gt2 = 0.f;
    {
        const int nrow = k;
        if (lane < nrow) { const int r = gw + lane * NGW;
            float lgv[16];
#pragma unroll
            for (int q = 0; q < 4; ++q) { const f32x4 t4 = *(const LAS f32x4*)(LG + (wave * 20 + lane) * 16 + 4 * q); lgv[4 * q] = t4[0]; lgv[4 * q + 1] = t4[1]; lgv[4 * q + 2] = t4[2]; lgv[4 * q + 3] = t4[3]; }
            float sc[16], bi[16];
#pragma unroll
            for (int e = 0; e < 16; ++e) { sc[e] = sigmoidf_(lgv[e]); bi[e] = sc[e] + p.in[I_ROUTB][e]; }
            int bg = 0; float bgs = -1e30f;
#pragma unroll
            for (int g = 0; g < 4; ++g) { float m1 = -1e30f, m2 = -1e30f;
#pragma unroll
                for (int i = 0; i < 4; ++i) { const float x = bi[4 * g + i]; if (x > m1) { m2 = m1; m1 = x; } else if (x > m2) m2 = x; }
                const float s = m1 + m2; if (s > bgs) { bgs = s; bg = g; } }
            int i1 = 0, i2 = 0; float m1 = -1e30f, m2 = -1e30f, s1 = 0.f, s2 = 0.f;
#pragma unroll
            for (int g = 0; g < 4; ++g) { const bool on = g == bg;
#pragma unroll
                for (int i = 0; i < 4; ++i) { const float x = bi[4 * g + i]; if (on && x > m1) { m1 = x; i1 = 4 * g + i; s1 = sc[4 * g + i]; } }
#pragma unroll
                for (int i = 0; i < 4; ++i) { const float x = bi[4 * g + i]; if (on && 4 * g + i != i1 && x > m2) { m2 = x; i2 = 4 * g + i; s2 = sc[4 * g + i]; } }
            }
            const int p1 = __hip_atomic_fetch_add(lcnt + i1, 1, __ATOMIC_RELAXED, __HIP_MEMORY_SCOPE_WORKGROUP), p2 = __hip_atomic_fetch_add(lcnt + i2, 1, __ATOMIC_RELAXED, __HIP_MEMORY_SCOPE_WORKGROUP);
            ent[(wave * 20 + lane) * 2] = i1 | (p1 << 8); ent[(wave * 20 + lane) * 2 + 1] = i2 | (p2 << 8);
            const float inv = frcp(s1 + s2);
            *(int2*)(TE + 2 * r) = make_int2(i1, i2); gt1 = s1 * inv; gt2 = s2 * inv;
        }
    }
    __syncthreads();
    if (tid < 16) lbase[tid] = (int)atomicAdd(cnt + tid, (unsigned)lcnt[tid]);
    __syncthreads();
    { const int r = gw + lane * NGW; if (r < T) { const int e1 = ent[(wave * 20 + lane) * 2], e2 = ent[(wave * 20 + lane) * 2 + 1];
        const int p1 = lbase[e1 & 255] + (e1 >> 8), p2 = lbase[e2 & 255] + (e2 >> 8);
        *(int2*)(TP + 2 * r) = make_int2(p1, p2);
        int* LIST = (int*)(ws + WS_LIST); float* GSL = (float*)(ws + WS_GSL);
        LIST[(e1 & 255) * T + p1] = r; GSL[(e1 & 255) * T + p1] = gt1; LIST[(e2 & 255) * T + p2] = r; GSL[(e2 & 255) * T + p2] = gt2; } }
    __syncthreads();
}
__device__ __forceinline__ void ph_ln2(const Params& p, int l, LAS unsigned char* lds, const int wvid) {
    const int bid = lt_bid(); unsigned char* const ws = lt_ptr(p.ws); (void)bid; (void)ws;
    const int tid = lt_tid(wvid), lane = tid & 63, wave = tid >> 6, gw = bid * NWAVE + wave, NGW = gridDim.x * NWAVE;
    bf16_t* HB = (bf16_t*)(ws + WS_HB); const bf16_t* Y2 = (const bf16_t*)(ws + WS_Y2); const int* TE = (const int*)(ws + WS_TOKE); const int* TP = (const int*)(ws + WS_TOKP);
    LAS int* tab = (LAS int*)lds;
    moe_table(ws, l, tab, wvid);
    const LnPar ln2 = ln_par(p.in[I_LN2G] + l * D, p.in[I_LN2B] + l * D, lane);
    int sl0 = 0, sl1 = 0; { const int myr = gw + lane * NGW; if (myr < T) { const int2 ee = *(const int2*)(TE + 2 * myr), pp = *(const int2*)(TP + 2 * myr); sl0 = tab[17 + ee.x] + pp.x; sl1 = tab[17 + ee.y] + pp.y; } }
    int k = 0;
    for (int r = gw; r < T; r += 4 * NGW, k += 4) {
        u32x2 hv[4][4], av[4][4], cv[4][4]; bool on[4];
#pragma unroll
        for (int q = 0; q < 4; ++q) { const int rr = r + q * NGW; const int t = rr % LT; on[q] = rr < T && !(l == NLAYER - 1 && t < NMETA);
            const int rc = rr < T ? rr : gw; const int s0 = __builtin_amdgcn_readlane(sl0, k + q), s1 = __builtin_amdgcn_readlane(sl1, k + q);
#pragma unroll
            for (int j = 0; j < 4; ++j) { hv[q][j] = *(const u32x2*)(HB + (size_t)rc * D + 4 * lane + 256 * j); av[q][j] = *(const u32x2*)(Y2 + (size_t)s0 * D + 4 * lane + 256 * j); cv[q][j] = *(const u32x2*)(Y2 + (size_t)s1 * D + 4 * lane + 256 * j); } }
#pragma unroll
        for (int q = 0; q < 4; ++q) { const int rr = r + q * NGW; if (!on[q]) continue; const int b = rr / LT, t = rr % LT;
            f32x4 v[4];
#pragma unroll
            for (int j = 0; j < 4; ++j) { const u32x2 h = hv[q][j], a = av[q][j], c = cv[q][j];
                v[j][0] = ALPHA * bflo(h.x) + bflo(a.x) + bflo(c.x); v[j][1] = ALPHA * bfhi(h.x) + bfhi(a.x) + bfhi(c.x); v[j][2] = ALPHA * bflo(h.y) + bflo(a.y) + bflo(c.y); v[j][3] = ALPHA * bfhi(h.y) + bfhi(a.y) + bfhi(c.y); }
            ln_affine(v, ln2);
            if (l == NLAYER - 1) { float* o = p.out + ((size_t)b * SEQ + (t - NMETA)) * D;
#pragma unroll
                for (int j = 0; j < 4; ++j) *(f32x4*)(o + 4 * lane + 256 * j) = v[j]; }
            else store_row_bf16(HB + (size_t)rr * D, v, lane); }
    }
}

#define XB_TMO      128
#define XB_XCNT(j)  (256  + 64 * (j))
#define XB_XSUB(j)  (1280 + 64 * (j))
#define XB_XGEN(j)  (2304 + 64 * (j))
#define XB_TOP      3328
#define XB_TOPGEN   3392
#define XCD_BAR_WORDS 3456
#define XB_SPIN_CAP (1u << 22)

__device__ __forceinline__ unsigned xb_ld(unsigned* p)              { return __hip_atomic_load(p, __ATOMIC_RELAXED, __HIP_MEMORY_SCOPE_AGENT); }
__device__ __forceinline__ unsigned xb_add(unsigned* p, unsigned v) { return __hip_atomic_fetch_add(p, v, __ATOMIC_RELAXED, __HIP_MEMORY_SCOPE_AGENT); }
__device__ __forceinline__ unsigned xb_xcc_id() { return (unsigned)__builtin_amdgcn_s_getreg((3 << 11) | 20) & 0xFu; }
#define XB_SPIN(cond, bar) do { unsigned _sp = 0; while (cond) { __builtin_amdgcn_s_sleep(1); \
    if ((++_sp & 255u) == 0u) { if (xb_ld(&(bar)[XB_TMO])) break; if (_sp > XB_SPIN_CAP) { atomicAdd(&(bar)[XB_TMO], 1u); break; } } } } while (0)

struct XcdBarrier {
    unsigned* bar; unsigned x;
    volatile LAS unsigned* st;
};

__device__ __forceinline__ XcdBarrier xcd_barrier_post(unsigned* bar, volatile LAS unsigned* st) {
    XcdBarrier b; b.bar = bar; b.x = xb_xcc_id(); b.st = st;
    if (threadIdx.x == 0) (void)xb_add(&bar[XB_XCNT(b.x)], 1u);
    return b;
}
__device__ __forceinline__ void xcd_barrier_complete(unsigned* bar, unsigned x, unsigned& nloc, unsigned& nx) {
    const unsigned G = gridDim.x * gridDim.y * gridDim.z;
    unsigned sum, cnt, mine, sp = 0u;
    for (;;) {
        sum = 0u; cnt = 0u; mine = 0u;
#pragma unroll
        for (unsigned j = 0; j < 16; ++j) { const unsigned c = xb_ld(&bar[XB_XCNT(j)]); sum += c; cnt += (c > 0u) ? 1u : 0u; mine = (j == x) ? c : mine; }
        if (sum == G) break;
        __builtin_amdgcn_s_sleep(1);
        if ((++sp & 255u) == 0u) { if (xb_ld(&bar[XB_TMO])) break; if (sp > XB_SPIN_CAP) { atomicAdd(&bar[XB_TMO], 1u); break; } }
    }
    nloc = mine > 0u ? mine : 1u; nx = cnt > 0u ? cnt : 1u;
}

__device__ __forceinline__ void xcd_barrier(const XcdBarrier& b) {
    asm volatile("s_waitcnt vmcnt(0)" ::: "memory");
    __syncthreads();
    if (threadIdx.x == 0) {
        unsigned* bar = b.bar;
        __builtin_amdgcn_s_waitcnt(0);
        unsigned nloc = b.st[0], nx = b.st[1];
        if (nloc == 0u) { xcd_barrier_complete(bar, b.x, nloc, nx); b.st[0] = nloc; b.st[1] = nx; }
        const unsigned old = xb_add(&bar[XB_XSUB(b.x)], 1u);
        const unsigned gen = old / nloc;
        if (old + 1u == (gen + 1u) * nloc) {
            __builtin_amdgcn_fence(__ATOMIC_RELEASE, "agent");
            asm volatile("s_waitcnt vmcnt(0)" ::: "memory");
            const unsigned og = xb_add(&bar[XB_TOP], 1u);
            const unsigned tg = og / nx;
            if (og + 1u == (tg + 1u) * nx) xb_add(&bar[XB_TOPGEN], 1u);
            else XB_SPIN(xb_ld(&bar[XB_TOPGEN]) == tg, bar);
            __builtin_amdgcn_fence(__ATOMIC_ACQUIRE, "agent");
            xb_add(&bar[XB_XGEN(b.x)], 1u);
            asm volatile("s_waitcnt vmcnt(0)" ::: "memory");
        } else {
            XB_SPIN(xb_ld(&bar[XB_XGEN(b.x)]) == gen, bar);
            __builtin_amdgcn_fence(__ATOMIC_ACQUIRE, "agent");
            asm volatile("s_waitcnt vmcnt(0)" ::: "memory");
        }
    }
    __syncthreads();
}


enum { PH_PROLOGUE = 0, PH_GEMM_IN, PH_PREP, PH_R2, PH_ATTN, PH_R4, PH_GEMM_OUT, PH_LN1, PH_SCATTER, PH_GEMM1, PH_GEMM2, PH_LN2 };
template <int PH> __global__ void __launch_bounds__(NTHR, 2) k_phase(Params p, int l) {
    extern __shared__ __attribute__((aligned(16))) unsigned char smem[];
    LAS unsigned char* lds = (LAS unsigned char*)smem;
    const int wvid = __builtin_amdgcn_readfirstlane((int)threadIdx.x >> 6);
    if (PH == PH_PROLOGUE) ph_prologue(p, lds, wvid);
    if (PH == PH_GEMM_IN) ph_gemm_in(p, l, lds, wvid);
    if (PH == PH_PREP) { ph_vt(p, l, lds, wvid); ph_conv2(p, l, lds, wvid); ph_rwkv_prep2(p, l, lds, wvid); }
    if (PH == PH_R2) ph_rwkv_chunk(p, l, lds, wvid);
    if (PH == PH_ATTN) { ph_rwkv_scan2(p, l, lds, (int)gridDim.x - 16, wvid); ph_diff2(p, l, lds, wvid); ph_swa2(p, l, lds, wvid); }
    if (PH == PH_R4) ph_rwkv_out(p, l, lds, wvid);
    if (PH == PH_GEMM_OUT) ph_gemm_out(p, l, lds, wvid);
    if (PH == PH_LN1) ph_ln1(p, l, lds, wvid);
    if (PH == PH_GEMM1) ph_gemm1(p, l, lds, wvid);
    if (PH == PH_GEMM2) ph_gemm2(p, l, lds, wvid);
    if (PH == PH_LN2) ph_ln2(p, l, lds, wvid);
}


__global__ void __launch_bounds__(NTHR, 2) k_fused(Params p) {
    extern __shared__ __attribute__((aligned(16))) unsigned char smem[];
    LAS unsigned char* lds = (LAS unsigned char*)smem;
    const int wvid = __builtin_amdgcn_readfirstlane((int)threadIdx.x >> 6);
    volatile LAS unsigned* st = (volatile LAS unsigned*)(lds + LDS_BYTES - 16);
    if (threadIdx.x == 0) { st[0] = 0u; st[1] = 0u; st[2] = 0u; st[3] = 0u; }
    __syncthreads();
    (void)xcd_barrier_post((unsigned*)(p.ws + WS_CTL) + CW_BAR, st);
#define GRID_SYNC() do { XcdBarrier _b; _b.bar = (unsigned*)(lt_ptr(p.ws) + WS_CTL) + CW_BAR; _b.x = xb_xcc_id(); _b.st = st; xcd_barrier(_b); } while (0)
    ph_prologue(p, lds, wvid); GRID_SYNC();
    if (PROBE_DUP == 14) { ph_prologue(p, lds, wvid); GRID_SYNC(); }
    for (int l = 0; l < NLAYER; ++l) {
        ph_gemm_in(p, l, lds, wvid); GRID_SYNC();
        if (PROBE_DUP == 1) { ph_gemm_in(p, l, lds, wvid); GRID_SYNC(); }
        ph_vt(p, l, lds, wvid); ph_conv2(p, l, lds, wvid); ph_rwkv_prep2(p, l, lds, wvid); GRID_SYNC();
        if (PROBE_DUP == 2) { ph_vt(p, l, lds, wvid); GRID_SYNC(); }
        if (PROBE_DUP == 3) { ph_conv2(p, l, lds, wvid); GRID_SYNC(); }
        if (PROBE_DUP == 4) { ph_rwkv_prep2(p, l, lds, wvid); GRID_SYNC(); }
        ph_rwkv_chunk(p, l, lds, wvid);
        if (PROBE_DUP == 5 || PROBE_DUP == 6) GRID_SYNC();
        if (PROBE_DUP == 5) { ph_rwkv_chunk(p, l, lds, wvid); GRID_SYNC(); }
        ph_rwkv_scan2(p, l, lds, (int)gridDim.x - 16, wvid); ph_diff2(p, l, lds, wvid); ph_swa2(p, l, lds, wvid); GRID_SYNC();
        if (PROBE_DUP == 6) { ph_rwkv_scan2(p, l, lds, (int)gridDim.x - 16, wvid); GRID_SYNC(); }
        if (PROBE_DUP == 7) { ph_diff2(p, l, lds, wvid, 1); GRID_SYNC(); }
        if (PROBE_DUP == 8) { ph_swa2(p, l, lds, wvid, 1); GRID_SYNC(); }
        ph_rwkv_out(p, l, lds, wvid); GRID_SYNC();
        if (PROBE_DUP == 9) { ph_rwkv_out(p, l, lds, wvid); GRID_SYNC(); }
        ph_gemm_out(p, l, lds, wvid); GRID_SYNC();
        if (PROBE_DUP == 10) { ph_gemm_out(p, l, lds, wvid); GRID_SYNC(); }
        ph_ln1(p, l, lds, wvid); GRID_SYNC();
        ph_gemm1(p, l, lds, wvid); GRID_SYNC();
        if (PROBE_DUP == 11) { ph_gemm1(p, l, lds, wvid); GRID_SYNC(); }
        ph_gemm2(p, l, lds, wvid); GRID_SYNC();
        if (PROBE_DUP == 12) { ph_gemm2(p, l, lds, wvid); GRID_SYNC(); }
        if (PROBE_DUP == 13) { GRID_SYNC(); GRID_SYNC(); GRID_SYNC(); GRID_SYNC(); GRID_SYNC(); GRID_SYNC(); GRID_SYNC(); GRID_SYNC(); GRID_SYNC(); GRID_SYNC(); }
        ph_ln2(p, l, lds, wvid); if (l + 1 < NLAYER) GRID_SYNC();
        if (PROBE_DUP == 16 && l + 1 == NLAYER) { GRID_SYNC(); ph_ln2(p, l, lds, wvid); GRID_SYNC(); ph_ln2(p, l, lds, wvid); }
    }
#undef GRID_SYNC
}

template <int PH> static void launch_phase(const Params& p, int l, int grid, hipStream_t stream) {
    static bool attr = false;
    if (!attr) { (void)hipFuncSetAttribute((const void*)k_phase<PH>, hipFuncAttributeMaxDynamicSharedMemorySize, LDS_BYTES); attr = true; }
    hipLaunchKernelGGL(k_phase<PH>, dim3(grid), dim3(NTHR), LDS_BYTES, stream, p, l);
}

extern "C" void kernel_launch(void* const* d_in, const int* in_sizes, int n_in, void* d_out, int out_size, void* d_ws, size_t ws_size, hipStream_t stream) {
    if (n_in != 37 || ws_size < WS_END) { fprintf(stderr, "kernel_launch: unexpected arguments (n_in %d, ws %zu, need %zu)\n", n_in, ws_size, (size_t)WS_END); return; }
    Params p{};
    for (int i = 0; i < 37; ++i) p.in[i] = (const float*)d_in[i];
    p.out = (float*)d_out; p.ws = (unsigned char*)d_ws;
    (void)hipMemsetAsync((char*)d_ws + WS_CTL, 0, CTL_BYTES, stream);
#if MK_ONE_LAUNCH
    static int grid = 0;
    if (!grid) {
        int dev = 0, cus = 0, per_cu = 0;
        (void)hipGetDevice(&dev); (void)hipDeviceGetAttribute(&cus, hipDeviceAttributeMultiprocessorCount, dev);
        (void)hipFuncSetAttribute((const void*)k_fused, hipFuncAttributeMaxDynamicSharedMemorySize, LDS_BYTES);
        (void)hipOccupancyMaxActiveBlocksPerMultiprocessor(&per_cu, (const void*)k_fused, NTHR, LDS_BYTES);
        if (per_cu < 1) fprintf(stderr, "kernel_launch: occupancy query reports %d workgroups per CU\n", per_cu);
        grid = cus > 0 ? cus : 256;
    }
    hipLaunchKernelGGL(k_fused, dim3(grid), dim3(NTHR), LDS_BYTES, stream, p);
#else
    const int grid = 256;
    launch_phase<PH_PROLOGUE>(p, 0, grid, stream);
    for (int l = 0; l < NLAYER; ++l) {
        launch_phase<PH_GEMM_IN>(p, l, grid, stream);
        launch_phase<PH_PREP>(p, l, grid, stream);
        launch_phase<PH_R2>(p, l, grid, stream);
        launch_phase<PH_ATTN>(p, l, grid, stream);
        launch_phase<PH_R4>(p, l, grid, stream);
        launch_phase<PH_GEMM_OUT>(p, l, grid, stream);
        launch_phase<PH_LN1>(p, l, grid, stream);
        launch_phase<PH_GEMM1>(p, l, grid, stream);
        launch_phase<PH_GEMM2>(p, l, grid, stream);
        launch_phase<PH_LN2>(p, l, grid, stream);
    }
#endif
}
```

```cpp
#include <hip/hip_runtime.h>
#include <stdint.h>
#include <stdio.h>

#ifndef PROBE_DUP
#define PROBE_DUP 0
#endif
#ifndef MK_ONE_LAUNCH
#define MK_ONE_LAUNCH 1
#endif

#define LAS __attribute__((address_space(3)))
typedef unsigned short bf16_t;
typedef short bf16x8 __attribute__((ext_vector_type(8)));
typedef float f32x4 __attribute__((ext_vector_type(4)));
typedef float f32x2 __attribute__((ext_vector_type(2)));
typedef unsigned u32x4 __attribute__((ext_vector_type(4)));
typedef unsigned u32x2 __attribute__((ext_vector_type(2)));

constexpr int D = 1024, NB = 8, SEQ = 4096, NMETA = 16, LT = SEQ + NMETA, T = NB * LT  , MP = 33024  ;
constexpr int INW = 2816, NLAYER = 2, NE = 16, FF = 512;
constexpr int NSLOT = 2 * T  , NSLOTP = NSLOT + 256;
constexpr float ALPHA = 1.41421356237f;
constexpr int C_QA = 0, C_KA = 256, C_VA = 384, C_QD = 512, C_KD = 768, C_VD = 1024, C_RW = 1280, C_CA = 2304, C_CG = 2560;
constexpr int M_A = 0, M_B = 256, M_C = 512, M_D = 768;

constexpr size_t AL(size_t x) { return (x + 255) & ~(size_t)255; }
constexpr size_t WS_CTL = 0, CTL_BYTES = 65536;
constexpr size_t WS_HB = WS_CTL + CTL_BYTES;
constexpr size_t WS_U = WS_HB + (size_t)MP * D * 2;
constexpr size_t WS_MIX = WS_U + (size_t)MP * INW * 2;
constexpr size_t WS_WIN = WS_MIX + (size_t)MP * D * 2;
constexpr size_t WS_WOUT = WS_WIN + (size_t)NLAYER * INW * D * 2;
constexpr size_t WS_W13 = WS_WOUT + (size_t)NLAYER * D * D * 2;
constexpr size_t WS_W2 = WS_W13 + (size_t)NLAYER * NE * 1024 * 1024 * 2;
constexpr size_t WS_TOKE = WS_W2 + (size_t)NLAYER * NE * 1024 * FF * 2;
constexpr size_t WS_TOKP = WS_TOKE + AL((size_t)T * 8);
constexpr size_t WS_TOKG = WS_TOKP + AL((size_t)T * 8);
constexpr size_t WS_LIST = WS_TOKG + AL((size_t)T * 8);
constexpr size_t WS_GSL = WS_LIST + AL((size_t)NE * T * 4);
constexpr size_t WS_RWB = WS_GSL + AL((size_t)NE * T * 4);
constexpr int LTP = 4160;
constexpr size_t WS_VTD = WS_RWB + (size_t)4 * T * 256 * 2;
constexpr size_t WS_VTA = WS_VTD + (size_t)NB * 4 * 64 * LTP * 2;
constexpr size_t WS_LORA = WS_VTA + (size_t)NB * 2 * 64 * LTP * 2;
constexpr size_t WS_END = WS_LORA + (size_t)NLAYER * 65536 * 2;
constexpr int RCH = 65, RUN = NB * 4 * RCH;
constexpr size_t RMB = (size_t)RUN * 64 * 64 * 2;
constexpr size_t RO_AT = 0, RO_BT = RMB, RO_KT = 2 * RMB, RO_RT = 3 * RMB, RO_VV = 4 * RMB, RO_PT = 5 * RMB, RO_QT = 6 * RMB, RO_SH = 0;
static_assert(7 * RMB <= (size_t)NB * SEQ * D * 4, "rwkv matrices in d_out");
constexpr size_t RW_GT = 0, RW_YL = RMB, RW_G = 2 * RMB, RW_BC = RW_G + (size_t)T * 256 * 2, RW_GC = RW_BC + (size_t)T * 4 * 4, RW_END = RW_GC + (size_t)RUN * 64 * 4;
static_assert(RW_END <= (size_t)4 * T * 256 * 2, "rwkv buffers in RWB");
constexpr size_t WS_Z = WS_U;
constexpr size_t WS_ZP = WS_U + (size_t)80 * 1024 * 1024;
constexpr int ZSPLIT = 4;
constexpr size_t WS_ACT = WS_U;
constexpr size_t WS_Y2 = WS_ACT + (size_t)NSLOTP * FF * 2;
static_assert(WS_Y2 + (size_t)NSLOTP * D * 2 <= WS_WIN, "moe alias");
static_assert(WS_END <= (size_t)536870912, "workspace");
constexpr int CW_BAR = 0;
constexpr int CW_CNT = 4096;
constexpr int CW_DQ = 4160;
constexpr int CW_SCD = 6400;
constexpr int CW_R2D = 6144;
constexpr int CW_KMX = 5120;
#define TM(t, j) ((((j) >> 4) << 10) + ((t) << 4) + ((j) & 15))
static_assert((size_t)3 * T * 256 * 4 <= (size_t)NB * SEQ * D * 4, "rwkv f32 temporaries");

struct Params { const float* in[37]; float* out; unsigned char* ws; };
enum { I_X = 0, I_META, I_LN0G, I_LN0B, I_WIN, I_SINKS, I_RELB, I_LQ1, I_LK1, I_LQ2, I_LK2, I_SUBLN, I_MU, I_W0, I_W2, I_A0, I_A2, I_G2, I_KK, I_KA, I_RK,
       I_LNXG, I_LNXB, I_CONVW, I_CONVB, I_GNG, I_GNB, I_WOUT, I_LN1G, I_LN1B, I_ROUTW, I_ROUTB, I_EW1, I_EW3, I_EW2, I_LN2G, I_LN2B };

__device__ __forceinline__ float bf2f(bf16_t b) { return __uint_as_float(((unsigned)b) << 16); }
__device__ __forceinline__ bf16_t f2bf(float f) { unsigned u = __float_as_uint(f); u += 0x7FFFu + ((u >> 16) & 1u); return (bf16_t)(u >> 16); }
__device__ __forceinline__ unsigned pk2(float lo, float hi) { return (unsigned)f2bf(lo) | ((unsigned)f2bf(hi) << 16); }
__device__ __forceinline__ float bflo(unsigned w) { return __uint_as_float(w << 16); }
__device__ __forceinline__ float bfhi(unsigned w) { return __uint_as_float(w & 0xFFFF0000u); }
template <int CTRL, int ROWMASK> __device__ __forceinline__ float dpp_add(float v) {
    return v + __int_as_float(__builtin_amdgcn_update_dpp(0, __float_as_int(v), CTRL, ROWMASK, 0xF, false));
}
template <int CTRL> __device__ __forceinline__ float dpp_get(float v) { return __int_as_float(__builtin_amdgcn_update_dpp(0, __float_as_int(v), CTRL, 0xF, 0xF, false)); }
__device__ __forceinline__ float row_sum16(float v) {
    v = dpp_add<0xB1, 0xF>(v); v = dpp_add<0x4E, 0xF>(v); v = dpp_add<0x141, 0xF>(v); v = dpp_add<0x140, 0xF>(v); return v;
}
__device__ __forceinline__ float wave_sum(float v) {
    v = row_sum16(v); v = dpp_add<0x142, 0xA>(v); v = dpp_add<0x143, 0xC>(v);
    return __int_as_float(__builtin_amdgcn_readlane(__float_as_int(v), 63));
}
__device__ __forceinline__ float half_sum32(float v) {
    v = row_sum16(v); v = dpp_add<0x142, 0xA>(v);
    const float lo = __int_as_float(__builtin_amdgcn_readlane(__float_as_int(v), 31)), hi = __int_as_float(__builtin_amdgcn_readlane(__float_as_int(v), 63));
    return (__builtin_amdgcn_mbcnt_hi(~0u, __builtin_amdgcn_mbcnt_lo(~0u, 0u)) < 32u) ? lo : hi;
}
__device__ __forceinline__ float frcp(float x) { return __builtin_amdgcn_rcpf(x); }
__device__ __forceinline__ float frsq(float x) { return __builtin_amdgcn_rsqf(x); }
__device__ __forceinline__ float sigmoidf_(float x) { return frcp(1.0f + __expf(-x)); }
__device__ __forceinline__ int t5_bucket(int n) {
    if (n < 16) return n;
    int b = 16;
    b += (n >= 19); b += (n >= 21); b += (n >= 24); b += (n >= 27); b += (n >= 31); b += (n >= 35); b += (n >= 40); b += (n >= 46);
    b += (n >= 52); b += (n >= 59); b += (n >= 67); b += (n >= 77); b += (n >= 87); b += (n >= 99); b += (n >= 113);
    return b;
}


__device__ __forceinline__ int lt_tid(int wv) { int ln; asm volatile("v_mbcnt_lo_u32_b32 %0, -1, 0\n\tv_mbcnt_hi_u32_b32 %0, -1, %0" : "=v"(ln)); return (wv << 6) | ln; }
__device__ __forceinline__ int lt_bid() { int b = blockIdx.x; asm volatile("" : "+s"(b)); return b; }
#define GAS __attribute__((address_space(1)))
__device__ __forceinline__ unsigned char* lt_ptr(unsigned char* q) { unsigned long long a = (unsigned long long)q; asm volatile("" : "+s"(a)); return (unsigned char*)(GAS unsigned char*)a; }
template <class Tp> __device__ __forceinline__ const Tp* gptr(const Tp* q) { return (const Tp*)(const GAS Tp*)(unsigned long long)q; }

namespace pg8 {
constexpr int BM = 256, BK = 64, HALF = 128, HTB = HALF * BK * 2, STAGE_BYTES = 8 * HTB, NXCD = 8, WGM = 8;
__host__ __device__ __forceinline__ int lds_byte(int r, int c) { const int st = (r >> 4) * 2 + (c >> 5), rr = r & 15, cc = c & 31, ob = rr * 64 + cc * 2; return st * 1024 + (ob ^ (((ob >> 9) & 1) << 5)); }
__host__ __device__ __forceinline__ void stage_rc(int b, int& R, int& C) { const int st = b / 1024, sb = b % 1024, swz = sb ^ (((sb >> 9) & 1) << 5); R = (st >> 1) * 16 + swz / 64; C = (st & 1) * 32 + (swz % 64) / 2; }
__host__ __device__ __forceinline__ int perm32(int rho) { const int n = rho >> 4, i = rho & 15; return 8 * (i >> 2) + 4 * n + (i & 3); }

struct Unit { int pn, row0, rend, e, koff, kt, loff; };

struct DenseOrder {
    int nM, nN, nwg, G, c, M; const bf16_t* Bt; int K, ksplit;
    __device__ void init(int M_, int N, int K_, const bf16_t* Bt_, int G_, int c_, int ksplit_ = 1) { M = M_; ksplit = ksplit_; nM = M_ / BM - (ksplit_ > 1 ? 1 : 0); nN = N / BM; nwg = nM * nN; G = G_; c = c_; Bt = Bt_; K = K_; }
    __device__ bool next(int i, Unit& u) const {
        const long L = (long)i * G + c;
        const int x = (int)(L - nwg); const bool tail = L >= nwg;
        if (tail && (ksplit <= 1 || x >= nN * ksplit)) return false;
        int wgid = tail ? 0 : (int)L; { const int q = nwg / NXCD, r = nwg % NXCD, xcd = wgid % NXCD, off = wgid / NXCD; wgid = (xcd < r ? xcd * (q + 1) : r * (q + 1) + (xcd - r) * q) + off; }
        const int nig = WGM * nN, gid = wgid / nig, fm = gid * WGM, gsz = (nM - fm) < WGM ? (nM - fm) : WGM;
        const int ks = tail ? x / nN : 0;
        u.row0 = tail ? nM * BM : (fm + ((wgid % nig) % gsz)) * BM; u.pn = tail ? x % nN : (wgid % nig) / gsz; u.rend = M; u.e = ks;
        u.koff = tail ? ks * (K / ksplit) : 0; u.kt = tail ? K / ksplit / BK : K / BK; u.loff = 0; return true;
    }
    __device__ __forceinline__ const char* b_ptr(const Unit& u) const { return (const char*)Bt + ((size_t)u.pn * BM * K + u.koff) * 2; }
    __device__ __forceinline__ unsigned a_row(const Unit& u, int r) const { return (unsigned)(u.row0 + r); }
};
struct MoeOrder {
    const LAS int* tab; int nN, G, c; const bf16_t* Bt; size_t bstride; int K; const int* list;
    __device__ bool next(int i, Unit& u) const {
        const long L0 = (long)i * G + c; const int ntile = tab[16], nwg = ntile * nN;
        if (L0 >= (long)nwg) return false;
        int L = (int)L0; { const int q = nwg / NXCD, r = nwg % NXCD, xcd = L % NXCD, off = L / NXCD; L = (xcd < r ? xcd * (q + 1) : r * (q + 1) + (xcd - r) * q) + off; }
        const int tile = L / nN; u.pn = L % nN;
        int e = 0;
#pragma unroll
        for (int k = 1; k < 16; ++k) e += (tab[k] <= tile) ? 1 : 0;
        u.e = e; u.row0 = tab[17 + e] + (tile - tab[e]) * BM; u.rend = tab[17 + e + 1]; u.koff = 0; u.kt = K / BK; u.loff = e * T - tab[17 + e]; return true;
    }
    __device__ __forceinline__ const char* b_ptr(const Unit& u) const { return (const char*)Bt + ((size_t)u.e * bstride + (size_t)u.pn * BM * K) * 2; }
    __device__ __forceinline__ unsigned a_row(const Unit& u, int r) const { return list ? (unsigned)list[u.loff + min(u.row0 + r, u.rend - 1)] : (unsigned)(u.row0 + r); }
};

typedef float f32x2c __attribute__((ext_vector_type(2))); typedef __bf16 bf16x2c __attribute__((ext_vector_type(2)));
__device__ __forceinline__ unsigned cvt_pk_bf16(float lo, float hi) { f32x2c v = {lo, hi}; bf16x2c b = __builtin_convertvector(v, bf16x2c); return __builtin_bit_cast(unsigned, b); }

struct EpiBf16 {
    static constexpr bool PERM = true;
    bf16_t* O; int ldc;
    __device__ __forceinline__ void operator()(const f32x4 (&acc)[2][2][4][2], const Unit& u, int wr, int wc, int fr, int fq) const {
        const int row0 = u.row0 + wr * 64 + fr, col0 = u.pn * BM + wc * 32 + 8 * fq;
#pragma unroll
        for (int ai = 0; ai < 2; ++ai)
#pragma unroll
            for (int m = 0; m < 4; ++m) { bf16_t* rowp = O + (size_t)(row0 + ai * HALF + m * 16) * ldc + col0;
#pragma unroll
                for (int bj = 0; bj < 2; ++bj) { const f32x4 v0 = acc[ai][bj][m][0], v1 = acc[ai][bj][m][1];
                    u32x4 w; w.x = cvt_pk_bf16(v0[0], v0[1]); w.y = cvt_pk_bf16(v0[2], v0[3]); w.z = cvt_pk_bf16(v1[0], v1[1]); w.w = cvt_pk_bf16(v1[2], v1[3]);
                    *(u32x4*)(rowp + bj * HALF) = w; } }
    }
};
struct EpiU {
    static constexpr bool PERM = true;
    bf16_t* O; bf16_t* VTD; bf16_t* VTA;
    __device__ __forceinline__ void operator()(const f32x4 (&acc)[2][2][4][2], const Unit& u, int wr, int wc, int fr, int fq) const {
        const int row0 = u.row0 + wr * 64 + fr, col0 = u.pn * BM + wc * 32 + 8 * fq;
#pragma unroll
        for (int ai = 0; ai < 2; ++ai)
#pragma unroll
            for (int m = 0; m < 4; ++m) { const int row = row0 + ai * HALF + m * 16; bf16_t* rowp = O + (size_t)row * INW + col0;
                const int b = row / LT, t = row - b * LT; const int tp = (t & ~12) | ((t & 4) << 1) | ((t & 8) >> 1);
#pragma unroll
                for (int bj = 0; bj < 2; ++bj) { const f32x4 v0 = acc[ai][bj][m][0], v1 = acc[ai][bj][m][1];
                    u32x4 w; w.x = cvt_pk_bf16(v0[0], v0[1]); w.y = cvt_pk_bf16(v0[2], v0[3]); w.z = cvt_pk_bf16(v1[0], v1[1]); w.w = cvt_pk_bf16(v1[2], v1[3]);
                    *(u32x4*)(rowp + bj * HALF) = w;
                    const int c = col0 + bj * HALF;
                    if (row < T && (u.pn == 4 || (u.pn == 1 && bj == 1))) {
                        bf16_t* vt = u.pn == 4 ? VTD + ((size_t)(b * 4 + ((c - C_VD) >> 6)) * 64 + ((c - C_VD) & 63)) * LTP + tp
                                               : VTA + ((size_t)(b * 2 + ((c - C_VA) >> 6)) * 64 + ((c - C_VA) & 63)) * LTP + tp;
                        const unsigned ww[4] = {w.x, w.y, w.z, w.w};
#pragma unroll
                        for (int e = 0; e < 4; ++e) { vt[(size_t)(2 * e) * LTP] = (bf16_t)ww[e]; vt[(size_t)(2 * e + 1) * LTP] = (bf16_t)(ww[e] >> 16); } } } }
    }
};
struct EpiZ {
    static constexpr bool PERM = true;
    bf16_t* Z; const bf16_t* hb; float* ZP; int Kfull;
    __device__ __forceinline__ void operator()(const f32x4 (&acc)[2][2][4][2], const Unit& u, int wr, int wc, int fr, int fq) const {
        const int row0 = u.row0 + wr * 64 + fr, col0 = u.pn * BM + wc * 32 + 8 * fq;
        if (u.kt * BK < Kfull) {
            float* zp = ZP + ((size_t)u.e * BM + (wr * 64 + fr)) * D + col0;
#pragma unroll
            for (int ai = 0; ai < 2; ++ai)
#pragma unroll
                for (int m = 0; m < 4; ++m)
#pragma unroll
                    for (int bj = 0; bj < 2; ++bj) { float* q = zp + (size_t)(ai * HALF + m * 16) * D + bj * HALF; *(f32x4*)q = acc[ai][bj][m][0]; *(f32x4*)(q + 4) = acc[ai][bj][m][1]; }
            return;
        }
#pragma unroll
        for (int ai = 0; ai < 2; ++ai)
#pragma unroll
            for (int m = 0; m < 4; ++m) { const size_t ro = (size_t)(row0 + ai * HALF + m * 16) * D + col0;
#pragma unroll
                for (int bj = 0; bj < 2; ++bj) { const u32x4 h = *(const u32x4*)(hb + ro + bj * HALF); const f32x4 v0 = acc[ai][bj][m][0], v1 = acc[ai][bj][m][1];
                    u32x4 w; w.x = cvt_pk_bf16(v0[0] + ALPHA * bflo(h.x), v0[1] + ALPHA * bfhi(h.x)); w.y = cvt_pk_bf16(v0[2] + ALPHA * bflo(h.y), v0[3] + ALPHA * bfhi(h.y));
                    w.z = cvt_pk_bf16(v1[0] + ALPHA * bflo(h.z), v1[1] + ALPHA * bfhi(h.z)); w.w = cvt_pk_bf16(v1[2] + ALPHA * bflo(h.w), v1[3] + ALPHA * bfhi(h.w));
                    *(u32x4*)(Z + ro + bj * HALF) = w; } }
    }
};
struct EpiAct {
    static constexpr bool PERM = true;
    bf16_t* A;
    __device__ __forceinline__ void operator()(const f32x4 (&acc)[2][2][4][2], const Unit& u, int wr, int wc, int fr, int fq) const {
        const int row0 = u.row0 + wr * 64 + fr, col0 = (u.pn * BM + wc * 32 + 8 * fq) >> 1;
        const int odd = fq & 1;
#pragma unroll
        for (int ai = 0; ai < 2; ++ai)
#pragma unroll
            for (int m = 0; m < 4; ++m) { const int row = row0 + ai * HALF + m * 16; bf16_t* rowp = A + (size_t)row * FF + col0;
                u32x2 w[2];
#pragma unroll
                for (int bj = 0; bj < 2; ++bj) { const f32x4 a = acc[ai][bj][m][0], b = acc[ai][bj][m][1]; float o[4];
#pragma unroll
                    for (int j = 0; j < 4; ++j) o[j] = a[j] * __builtin_amdgcn_rcpf(1.0f + __expf(-a[j])) * b[j];
                    w[bj].x = cvt_pk_bf16(o[0], o[1]); w[bj].y = cvt_pk_bf16(o[2], o[3]); }
                const auto rx = __builtin_amdgcn_permlane16_swap(w[0].x, w[1].x, false, false); const auto ry = __builtin_amdgcn_permlane16_swap(w[0].y, w[1].y, false, false);
                u32x4 v; v.x = rx[0]; v.y = ry[0]; v.z = rx[1]; v.w = ry[1];
                if (row < u.rend) *(u32x4*)(rowp + (odd ? HALF / 2 - 4 : 0)) = v; }
    }
};
struct EpiY2 {
    static constexpr bool PERM = true;
    bf16_t* Y; const float* gate;
    __device__ __forceinline__ void operator()(const f32x4 (&acc)[2][2][4][2], const Unit& u, int wr, int wc, int fr, int fq) const {
        const int row0 = u.row0 + wr * 64 + fr, col0 = u.pn * BM + wc * 32 + 8 * fq;
        float gt[2][4];
#pragma unroll
        for (int ai = 0; ai < 2; ++ai)
#pragma unroll
            for (int m = 0; m < 4; ++m) gt[ai][m] = gate[u.loff + min(row0 + ai * HALF + m * 16, u.rend - 1)];
#pragma unroll
        for (int ai = 0; ai < 2; ++ai)
#pragma unroll
            for (int m = 0; m < 4; ++m) { const int row = row0 + ai * HALF + m * 16; if (row < u.rend) { const float g = gt[ai][m]; bf16_t* rowp = Y + (size_t)row * D + col0;
#pragma unroll
                for (int bj = 0; bj < 2; ++bj) { const f32x4 v0 = acc[ai][bj][m][0] * g, v1 = acc[ai][bj][m][1] * g;
                    u32x4 w; w.x = cvt_pk_bf16(v0[0], v0[1]); w.y = cvt_pk_bf16(v0[2], v0[3]); w.z = cvt_pk_bf16(v1[0], v1[1]); w.w = cvt_pk_bf16(v1[2], v1[3]);
                    *(u32x4*)(rowp + bj * HALF) = w; } } }
    }
};

template <class Epi, class Sched>
__device__ __forceinline__ void gemm_phase(LAS unsigned char* lds, const bf16_t* Abase, const int K, const Sched& S, const Epi& E, const int wvid) {
    const int tid = lt_tid(wvid), wid = __builtin_amdgcn_readfirstlane(tid >> 6), lane = tid & 63, wr = wid >> 2, wc = wid & 3, fr = lane & 15, fq = lane >> 4;
    unsigned voffB[2];
#pragma unroll
    for (int i = 0; i < 2; ++i) { int R, C; stage_rc(tid * 16 + i * 8192, R, C); const int Rb = Epi::PERM ? ((R & ~31) + perm32(R & 31)) : R;
        voffB[i] = (unsigned)(Rb * K + C) * 2u; }
    const size_t kstep = (size_t)(BK * 2);
    const size_t hstep = (size_t)HALF * K * 2;
    const unsigned ldsw = (unsigned)wid * 1024u;
    const int aoff = lds_byte(wr * 64 + fr, fq * 8), boff = lds_byte(wc * 32 + fr, fq * 8);
#define PG8_SA(b, h) (((b) * 2 + (h)) * HTB)
#define PG8_SB(b, h) ((4 + (b) * 2 + (h)) * HTB)
#define PG8_STAGE(bufoff, gbase, voff) do { _Pragma("unroll") for (int _i = 0; _i < 2; ++_i) \
        __builtin_amdgcn_global_load_lds((const unsigned*)((const char*)(gbase) + (voff)[_i]), (LAS unsigned*)(lds + (bufoff) + ldsw + _i * 8192), 16, 0, 0); } while (0)
#define PG8_LDA(dst, b, h) do { _Pragma("unroll") for (int m = 0; m < 4; ++m) _Pragma("unroll") for (int k = 0; k < 2; ++k) dst[m][k] = *(const LAS bf16x8*)(lds + PG8_SA(b, h) + aoff + m * 2048 + k * 1024); } while (0)
#define PG8_LDB(dst, b, h) do { _Pragma("unroll") for (int n = 0; n < 2; ++n) _Pragma("unroll") for (int k = 0; k < 2; ++k) dst[n][k] = *(const LAS bf16x8*)(lds + PG8_SB(b, h) + boff + n * 2048 + k * 1024); } while (0)
#define PG8_MMA(ai, bj, At, Bt) do { __builtin_amdgcn_s_setprio(1); _Pragma("unroll") for (int m = 0; m < 4; ++m) _Pragma("unroll") for (int n = 0; n < 2; ++n) _Pragma("unroll") for (int k = 0; k < 2; ++k) \
        acc[ai][bj][m][n] = __builtin_amdgcn_mfma_f32_16x16x32_bf16(Bt[n][k], At[m][k], acc[ai][bj][m][n], 0, 0, 0); __builtin_amdgcn_s_setprio(0); } while (0)
#define PG8_WAIT_V(n) asm volatile("s_waitcnt vmcnt(" #n ")" ::: "memory")
#define PG8_WAIT_L(n) asm volatile("s_waitcnt lgkmcnt(" #n ")" ::: "memory")
#define PG8_BAR __builtin_amdgcn_s_barrier()
#define PG8_SCHED __builtin_amdgcn_sched_barrier(0)
#define PG8_AOFF(u) do { const int _t = lt_tid(wvid); _Pragma("unroll") for (int _i = 0; _i < 2; ++_i) { int _R, _C; stage_rc(_t * 16 + _i * 8192, _R, _C); \
        _Pragma("unroll") for (int _h = 0; _h < 2; ++_h) voffA[_h][_i] = (S.a_row(u, _h * HALF + _R) * (unsigned)K + (unsigned)(_C + (u).koff)) * 2u; } } while (0)
    Unit cur, nxt; int ui = 0;
    if (!S.next(0, cur)) return;
    f32x4 acc[2][2][4][2];
#pragma unroll
    for (int a = 0; a < 2; ++a)
#pragma unroll
        for (int b = 0; b < 2; ++b)
#pragma unroll
            for (int m = 0; m < 4; ++m)
#pragma unroll
                for (int n = 0; n < 2; ++n) acc[a][b][m][n] = (f32x4){0.f, 0.f, 0.f, 0.f};
    bf16x8 At[4][2], B0[2][2], B1[2][2];
    unsigned voffA[2][2];
    PG8_AOFF(cur);
    const char* Ab = (const char*)Abase;
    const char* cB = S.b_ptr(cur);
    PG8_STAGE(PG8_SB(0, 0), cB, voffB); PG8_STAGE(PG8_SA(0, 0), Ab, voffA[0]); PG8_STAGE(PG8_SB(0, 1), cB + hstep, voffB); PG8_STAGE(PG8_SA(0, 1), Ab, voffA[1]);
    if (wr == 1) PG8_BAR;
    PG8_WAIT_V(4); PG8_BAR;
    PG8_STAGE(PG8_SB(1, 0), cB + kstep, voffB); PG8_STAGE(PG8_SA(1, 0), Ab + kstep, voffA[0]); PG8_STAGE(PG8_SB(1, 1), cB + hstep + kstep, voffB);
    PG8_WAIT_V(6); PG8_BAR;
    for (;;) {
        const bool has_next = S.next(ui + 1, nxt);
        const char* nB = has_next ? S.b_ptr(nxt) : cB;
        const int nt = cur.kt;
        for (int t = 0; t < nt; t += 2) {
            const bool last = (t == nt - 2);
            const char* a1 = Ab + (size_t)(t + 1) * kstep;
            PG8_LDB(B0, 0, 0); PG8_SCHED; PG8_LDA(At, 0, 0); PG8_STAGE(PG8_SA(1, 1), a1, voffA[1]);
            PG8_WAIT_L(8); PG8_BAR; PG8_WAIT_L(0); PG8_MMA(0, 0, At, B0); PG8_BAR; PG8_SCHED;
            if (last && has_next) PG8_AOFF(nxt);
            const char* a2 = last ? Ab : Ab + (size_t)(t + 2) * kstep; const char* b2 = last ? nB : cB + (size_t)(t + 2) * kstep;
            const char* a3 = a2 + kstep; const char* b3 = b2 + kstep;
            PG8_LDB(B1, 0, 1); PG8_STAGE(PG8_SB(0, 0), b2, voffB);
            PG8_BAR; PG8_WAIT_L(0); PG8_MMA(0, 1, At, B1); PG8_BAR;
            PG8_LDA(At, 0, 1); PG8_STAGE(PG8_SA(0, 0), a2, voffA[0]);
            PG8_BAR; PG8_WAIT_L(0); PG8_MMA(1, 0, At, B0); PG8_BAR; PG8_SCHED;
            PG8_STAGE(PG8_SB(0, 1), b2 + hstep, voffB);
            PG8_WAIT_V(6); PG8_BAR; PG8_MMA(1, 1, At, B1); PG8_BAR;
            PG8_LDB(B0, 1, 0); PG8_SCHED; PG8_LDA(At, 1, 0); PG8_STAGE(PG8_SA(0, 1), a2, voffA[1]);
            PG8_WAIT_L(8); PG8_BAR; PG8_WAIT_L(0); PG8_MMA(0, 0, At, B0); PG8_BAR; PG8_SCHED;
            PG8_LDB(B1, 1, 1); PG8_STAGE(PG8_SB(1, 0), b3, voffB);
            PG8_BAR; PG8_WAIT_L(0); PG8_MMA(0, 1, At, B1); PG8_BAR;
            PG8_LDA(At, 1, 1); PG8_STAGE(PG8_SA(1, 0), a3, voffA[0]);
            PG8_BAR; PG8_WAIT_L(0); PG8_MMA(1, 0, At, B0); PG8_BAR; PG8_SCHED;
            PG8_STAGE(PG8_SB(1, 1), b3 + hstep, voffB);
            PG8_WAIT_V(6); PG8_BAR; PG8_MMA(1, 1, At, B1); PG8_BAR;
        }
        E(acc, cur, wr, wc, fr, fq);
        if (!has_next) break;
#pragma unroll
        for (int a = 0; a < 2; ++a)
#pragma unroll
            for (int b = 0; b < 2; ++b)
#pragma unroll
                for (int m = 0; m < 4; ++m)
#pragma unroll
                    for (int n = 0; n < 2; ++n) acc[a][b][m][n] = (f32x4){0.f, 0.f, 0.f, 0.f};
        cur = nxt; cB = nB; ++ui;
    }
    PG8_WAIT_V(0);
    if (wr == 0) PG8_BAR;
    PG8_BAR;
#undef PG8_SA
#undef PG8_SB
#undef PG8_STAGE
#undef PG8_LDA
#undef PG8_LDB
#undef PG8_MMA
#undef PG8_WAIT_V
#undef PG8_WAIT_L
#undef PG8_BAR
#undef PG8_SCHED
#undef PG8_AOFF
}
}

constexpr int NTHR = 512, NWAVE = 8;
constexpr int LDS_BYTES = 155648;

struct TrItem { const float* W; bf16_t* WT; int K, N, mode, item; };
__device__ __forceinline__ void tr_load(const TrItem& t, float (&v)[32], int lane) {
    const int nblk = t.N / 32, kb = t.item / nblk, nb = t.item % nblk, k0 = 64 * kb, n0 = 32 * nb;
#pragma unroll
    for (int i = 0; i < 32; ++i) v[i] = t.W[(size_t)(k0 + 2 * i + (lane >> 5)) * t.N + n0 + (lane & 31)];
}
__device__ __forceinline__ void tr_finish(const TrItem& t, const float (&v)[32], LAS float* scr, int lane) {
    const int nblk = t.N / 32, kb = t.item / nblk, nb = t.item % nblk, k0 = 64 * kb, n0 = 32 * nb;
#pragma unroll
    for (int i = 0; i < 32; ++i) scr[(2 * i + (lane >> 5)) * 33 + (lane & 31)] = v[i];
    asm volatile("s_waitcnt lgkmcnt(0)" ::: "memory");
    const int c = lane & 7;
#pragma unroll
    for (int j = 0; j < 4; ++j) { const int n = (lane >> 3) + 8 * j; const LAS float* s = scr + (8 * c) * 33 + n;
        u32x4 o; o.x = pk2(s[0 * 33], s[1 * 33]); o.y = pk2(s[2 * 33], s[3 * 33]); o.z = pk2(s[4 * 33], s[5 * 33]); o.w = pk2(s[6 * 33], s[7 * 33]);
        const int ng = n0 + n; const int row = t.mode == 0 ? ng : (8 * (ng >> 2) + (ng & 3) + (t.mode == 2 ? 4 : 0));
        *(u32x4*)(t.WT + (size_t)row * t.K + k0 + 8 * c) = o; }
    asm volatile("s_waitcnt lgkmcnt(0)" ::: "memory");
}
struct LnPar { f32x4 g[4], b[4]; };
__device__ __forceinline__ LnPar ln_par(const float* g, const float* b, int lane) { LnPar q;
#pragma unroll
    for (int j = 0; j < 4; ++j) { q.g[j] = *(const f32x4*)(g + 4 * lane + 256 * j); q.b[j] = *(const f32x4*)(b + 4 * lane + 256 * j); }
    return q; }
__device__ __forceinline__ void ln_affine(f32x4 (&v)[4], const LnPar& q) {
    float s = 0.f;
#pragma unroll
    for (int j = 0; j < 4; ++j) s += (v[j][0] + v[j][1]) + (v[j][2] + v[j][3]);
    const float mean = wave_sum(s) * (1.f / D); float s2 = 0.f;
#pragma unroll
    for (int j = 0; j < 4; ++j) { v[j] = v[j] - mean; s2 += (v[j][0] * v[j][0] + v[j][1] * v[j][1]) + (v[j][2] * v[j][2] + v[j][3] * v[j][3]); }
    const float rstd = frsq(wave_sum(s2) * (1.f / D) + 1e-5f);
#pragma unroll
    for (int j = 0; j < 4; ++j) v[j] = v[j] * rstd * q.g[j] + q.b[j];
}
__device__ __forceinline__ void store_row_bf16(bf16_t* row, const f32x4 (&v)[4], int lane) {
#pragma unroll
    for (int j = 0; j < 4; ++j) { u32x2 w; w.x = pk2(v[j][0], v[j][1]); w.y = pk2(v[j][2], v[j][3]); *(u32x2*)(row + 4 * lane + 256 * j) = w; }
}
constexpr int TRN_WIN = 16 * 88, TRN_WOUT = 16 * 32, TRN_W1 = 16 * 16, TRN_W2 = 8 * 32, TRN_EXP = 2 * TRN_W1 + TRN_W2, TRN_LAYER = TRN_WIN + TRN_WOUT + NE * TRN_EXP;
template <int GRP> __device__ __forceinline__ constexpr int tr_count() {
    return GRP == 0 ? TRN_WIN : GRP == 1 ? TRN_WOUT + 4 * 2 * TRN_W1 : GRP == 2 ? NE * TRN_W2 + TRN_WIN + TRN_WOUT : GRP == 5 ? NE * TRN_W2 : GRP == 6 ? 12 * 2 * TRN_W1 : (NE / 2) * 2 * TRN_W1; }
template <int GRP> __device__ __forceinline__ int tr_index(int g) {
    constexpr int EX0 = TRN_WIN + TRN_WOUT, W13N = 2 * TRN_W1;
    if (GRP == 0) return g;
    if (GRP == 1) { if (g < TRN_WOUT) return TRN_WIN + g; const int q = g - TRN_WOUT; return EX0 + (q / W13N) * TRN_EXP + q % W13N; }
    if (GRP == 6) return EX0 + (4 + g / W13N) * TRN_EXP + g % W13N;
    if (GRP == 2) { if (g < NE * TRN_W2) return EX0 + (g / TRN_W2) * TRN_EXP + W13N + g % TRN_W2; return TRN_LAYER + (g - NE * TRN_W2); }
    if (GRP == 3 || GRP == 4) return TRN_LAYER + EX0 + ((GRP == 4 ? NE / 2 : 0) + g / W13N) * TRN_EXP + g % W13N;
    return TRN_LAYER + EX0 + (g / TRN_W2) * TRN_EXP + W13N + g % TRN_W2;
}
__device__ __forceinline__ TrItem tr_decode(const Params& p, unsigned char* ws, int it) {
    bf16_t* WIN = (bf16_t*)(ws + WS_WIN); bf16_t* WOUT = (bf16_t*)(ws + WS_WOUT); bf16_t* W13 = (bf16_t*)(ws + WS_W13); bf16_t* W2 = (bf16_t*)(ws + WS_W2);
    const int l = it / TRN_LAYER; int r = it % TRN_LAYER; TrItem t;
    if (r < TRN_WIN) { t.W = p.in[I_WIN] + (size_t)l * D * INW; t.WT = WIN + (size_t)l * INW * D; t.K = D; t.N = INW; t.mode = 0; t.item = r; return t; } r -= TRN_WIN;
    if (r < TRN_WOUT) { t.W = p.in[I_WOUT] + (size_t)l * D * D; t.WT = WOUT + (size_t)l * D * D; t.K = D; t.N = D; t.mode = 0; t.item = r; return t; } r -= TRN_WOUT;
    const int e = r / TRN_EXP, q = r % TRN_EXP; const size_t le = (size_t)l * NE + e;
    if (q < TRN_W1) { t.W = p.in[I_EW1] + le * D * FF; t.WT = W13 + le * 1024 * 1024; t.K = D; t.N = FF; t.mode = 1; t.item = q; }
    else if (q < 2 * TRN_W1) { t.W = p.in[I_EW3] + le * D * FF; t.WT = W13 + le * 1024 * 1024; t.K = D; t.N = FF; t.mode = 2; t.item = q - TRN_W1; }
    else { t.W = p.in[I_EW2] + le * FF * D; t.WT = W2 + le * 1024 * FF; t.K = FF; t.N = D; t.mode = 0; t.item = q - 2 * TRN_W1; }
    return t;
}
template <int GRP> __device__ __forceinline__ void tr_group(const Params& p, unsigned char* ws, LAS float* scr, int lane, int start, int stride) {
    float cur[32], nx1[32], nx2[32]; int g = start; constexpr int N = tr_count<GRP>();
    if (g < N) { const TrItem t0 = tr_decode(p, ws, tr_index<GRP>(g)); tr_load(t0, cur, lane); }
    if (g + stride < N) { const TrItem t1 = tr_decode(p, ws, tr_index<GRP>(g + stride)); tr_load(t1, nx1, lane); }
    while (g < N) { const int g2 = g + 2 * stride;
        if (g2 < N) { const TrItem tn = tr_decode(p, ws, tr_index<GRP>(g2)); tr_load(tn, nx2, lane); }
        const TrItem tc = tr_decode(p, ws, tr_index<GRP>(g)); tr_finish(tc, cur, scr, lane);
#pragma unroll
        for (int i = 0; i < 32; ++i) { cur[i] = nx1[i]; nx1[i] = nx2[i]; }
        g += stride; }
}
template <int GRP> __device__ __forceinline__ void tr_in_rwkv_idle(const Params& p, unsigned char* ws, LAS unsigned char* lds, int bid, const int wvid) {
    if ((bid & 7) == 0) return;
    const int G = (int)gridDim.x, n = G - (G + 7) / 8, rank = bid - (bid >> 3) - 1;
    __syncthreads();
    const int tid = lt_tid(wvid), lane = tid & 63, wave = tid >> 6;
    tr_group<GRP>(p, ws, (LAS float*)(lds + wave * 8704), lane, rank * NWAVE + wave, n * NWAVE);
}
template <int GRP> __device__ __forceinline__ void tr_in_tail(const Params& p, unsigned char* ws, LAS unsigned char* lds, int total, int bid, const int wvid) {
    const int G = (int)gridDim.x, R = (total + G - 1) / G, c0 = total - (R - 1) * G;
    const int first = c0 >= G ? 0 : c0, n = G - first;
    if (bid < first) return;
    const int tid = lt_tid(wvid), lane = tid & 63, wave = tid >> 6;
    tr_group<GRP>(p, ws, (LAS float*)(lds + wave * 8704), lane, (bid - first) * NWAVE + wave, n * NWAVE);
}
__device__ __forceinline__ void ph_prologue(const Params& p, LAS unsigned char* lds, const int wvid) {
    const int bid = lt_bid(); unsigned char* const ws = lt_ptr(p.ws); (void)bid; (void)ws;
    const int tid = lt_tid(wvid), lane = tid & 63, wave = tid >> 6, gw = bid * NWAVE + wave, NGW = gridDim.x * NWAVE;
    LAS float* scr = (LAS float*)(lds + wave * 8704);
    tr_group<0>(p, ws, scr, lane, gw, NGW);
    {
        bf16_t* VT = (bf16_t*)(ws + WS_VTD);
        for (int i = bid * NTHR + tid; i < NB * 6 * 64 * (LTP - LT); i += gridDim.x * NTHR) { const int r = i / (LTP - LT), k = i % (LTP - LT); VT[(size_t)r * LTP + LT + k] = 0; }
    }
    {
        bf16_t* LW = (bf16_t*)(ws + WS_LORA);
        for (int i = bid * NTHR + tid; i < NLAYER * 65536; i += gridDim.x * NTHR) {
            const int l = i >> 16, r = i & 65535; float v;
            if (r < 16384) { const int c = r >> 6, k = r & 63; v = p.in[I_W2][(size_t)l * 16384 + k * 256 + c]; }
            else if (r < 32768) { const int q = r - 16384, c = q >> 6, k = q & 63; v = p.in[I_A2][(size_t)l * 16384 + k * 256 + c]; }
            else { const int q = r - 32768, c = q >> 7, k = q & 127; v = p.in[I_G2][(size_t)l * 32768 + k * 256 + c]; }
            int pos; if (r < 16384) { const int c = r >> 6, k = r & 63; pos = (k >> 4) * 4096 + c * 16 + (k & 15); }
            else if (r < 32768) { const int q = r - 16384, c = q >> 6, k = q & 63; pos = 16384 + (k >> 4) * 4096 + c * 16 + (k & 15); }
            else { const int q = r - 32768, c = q >> 7, k = q & 127; pos = 32768 + (k >> 4) * 4096 + c * 16 + (k & 15); }
            LW[(size_t)l * 65536 + pos] = f2bf(v); }
    }
    bf16_t* HB = (bf16_t*)(ws + WS_HB); bf16_t* MIX = (bf16_t*)(ws + WS_MIX);
    const LnPar ln0 = ln_par(p.in[I_LN0G], p.in[I_LN0B], lane);
    auto row_src = [&](int r) -> const float* { const int rc = r < T ? r : 0; const int b = rc / LT, t = rc % LT; return t < NMETA ? p.in[I_META] + (size_t)t * D : p.in[I_X] + ((size_t)b * SEQ + (t - NMETA)) * D; };
    f32x4 vn[4];
    { const float* src = row_src(gw);
#pragma unroll
      for (int j = 0; j < 4; ++j) vn[j] = *(const f32x4*)(src + 4 * lane + 256 * j); }
    for (int r = gw; r < MP; r += NGW) {
        f32x4 v[4];
        { const float* src = row_src(r + NGW < MP ? r + NGW : r);
#pragma unroll
          for (int j = 0; j < 4; ++j) { v[j] = vn[j]; vn[j] = *(const f32x4*)(src + 4 * lane + 256 * j); } }
        if (r >= T) {
#pragma unroll
            for (int j = 0; j < 4; ++j) v[j] = (f32x4){0.f, 0.f, 0.f, 0.f};
            store_row_bf16(MIX + (size_t)r * D, v, lane);
        } else ln_affine(v, ln0);
        store_row_bf16(HB + (size_t)r * D, v, lane);
    }
}

__device__ __forceinline__ void ph_gemm_in(const Params& p, int l, LAS unsigned char* lds, const int wvid) {
    const int bid = lt_bid(); unsigned char* const ws = lt_ptr(p.ws); (void)bid; (void)ws;
    pg8::DenseOrder S; S.init(MP, INW, D, (const bf16_t*)(ws + WS_WIN) + (size_t)l * INW * D, gridDim.x, bid);
    pg8::EpiU E{(bf16_t*)(ws + WS_U), (bf16_t*)(ws + WS_VTD), (bf16_t*)(ws + WS_VTA)};
    pg8::gemm_phase(lds, (const bf16_t*)(ws + WS_HB), D, S, E, wvid);
    if (l == 0) tr_in_tail<1>(p, ws, lds, (MP / 256) * (INW / 256), bid, wvid); else tr_in_tail<4>(p, ws, lds, (MP / 256) * (INW / 256), bid, wvid);
}
__device__ __forceinline__ void ph_gemm_out(const Params& p, int l, LAS unsigned char* lds, const int wvid) {
    const int bid = lt_bid(); unsigned char* const ws = lt_ptr(p.ws); (void)bid; (void)ws;
    pg8::DenseOrder S; S.init(MP, D, D, (const bf16_t*)(ws + WS_WOUT) + (size_t)l * D * D, gridDim.x, bid, ZSPLIT);
    pg8::EpiZ E{(bf16_t*)(ws + WS_Z), (const bf16_t*)(ws + WS_HB), (float*)(ws + WS_ZP), D};
    pg8::gemm_phase(lds, (const bf16_t*)(ws + WS_MIX), D, S, E, wvid);
}
__device__ __forceinline__ void moe_table(unsigned char* ws, int l, LAS int* tab, const int wvid) {
    const int t = lt_tid(wvid);
    __syncthreads();
    if (t < 16) tab[40 + t] = (int)__hip_atomic_load((const unsigned*)(ws + WS_CTL) + CW_CNT + l * 16 + t, __ATOMIC_RELAXED, __HIP_MEMORY_SCOPE_AGENT);
    __syncthreads();
    if (t == 0) {
        int ts = 0, ss = 0;
        for (int e = 0; e < 16; ++e) { const int c = tab[40 + e]; tab[e] = ts; tab[17 + e] = ss; ts += (c + 255) >> 8; ss += c; }
        tab[16] = ts; tab[33] = ss;
    }
    __syncthreads();
}
__device__ __forceinline__ void ph_gemm1(const Params& p, int l, LAS unsigned char* lds, const int wvid) {
    const int bid = lt_bid(); unsigned char* const ws = lt_ptr(p.ws); (void)bid; (void)ws;
    LAS int* tab = (LAS int*)(lds + pg8::STAGE_BYTES);
    moe_table(ws, l, tab, wvid);
    pg8::MoeOrder S{tab, 4, (int)gridDim.x, (int)bid, (const bf16_t*)(ws + WS_W13) + (size_t)l * NE * 1024 * 1024, (size_t)1024 * 1024, D, (const int*)(ws + WS_LIST)};
    pg8::EpiAct E{(bf16_t*)(ws + WS_ACT)};
    pg8::gemm_phase(lds, (const bf16_t*)(ws + WS_HB), D, S, E, wvid);
    if (l == 0) tr_in_tail<2>(p, ws, lds, tab[16] * 4, bid, wvid); else tr_in_tail<5>(p, ws, lds, tab[16] * 4, bid, wvid);
}
__device__ __forceinline__ void ph_gemm2(const Params& p, int l, LAS unsigned char* lds, const int wvid) {
    const int bid = lt_bid(); unsigned char* const ws = lt_ptr(p.ws); (void)bid; (void)ws;
    LAS int* tab = (LAS int*)(lds + pg8::STAGE_BYTES);
    moe_table(ws, l, tab, wvid);
    pg8::MoeOrder S{tab, 4, (int)gridDim.x, (int)bid, (const bf16_t*)(ws + WS_W2) + (size_t)l * NE * 1024 * FF, (size_t)1024 * FF, FF, nullptr};
    pg8::EpiY2 E{(bf16_t*)(ws + WS_Y2), (const float*)(ws + WS_GSL)};
    pg8::gemm_phase(lds, (const bf16_t*)(ws + WS_ACT), FF, S, E, wvid);
    if (l == 0) tr_in_tail<3>(p, ws, lds, tab[16] * 4, bid, wvid);
}

__device__ __forceinline__ void load8(const bf16_t* p, float* o) { const u32x4 w = *(const u32x4*)p; o[0] = bflo(w.x); o[1] = bfhi(w.x); o[2] = bflo(w.y); o[3] = bfhi(w.y); o[4] = bflo(w.z); o[5] = bfhi(w.z); o[6] = bflo(w.w); o[7] = bfhi(w.w); }
template <int NH>
__device__ __forceinline__ void vt_pass(const bf16_t* U, bf16_t* VT, int colbase, LAS unsigned char* lds, int bid, int tid) {
    constexpr int PITCH = NH * 128 + 16, NCH = NH * 8  , NIT = 64 * NCH / NTHR;
    for (int unit = bid; unit < NB * (LTP / 64); unit += gridDim.x) {
        const int b = unit / (LTP / 64), k0 = (unit % (LTP / 64)) * 64;
        __syncthreads();
#pragma unroll
        for (int q = 0; q < NIT; ++q) { const int it = tid + q * NTHR, row = it / NCH, ch = it % NCH;
            u32x4 v = *(const u32x4*)(U + ((size_t)b * LT + min(k0 + row, LT - 1)) * INW + colbase + ch * 8);
            if (k0 + row >= LT) v = (u32x4){0u, 0u, 0u, 0u};
            *(LAS u32x4*)(lds + row * PITCH + ch * 16) = v; }
        __syncthreads();
#pragma unroll
        for (int q = 0; q < NIT; ++q) { const int it = tid + q * NTHR, col = it >> 3, g = (it >> 1) & 3, hh = it & 1;
            unsigned short e[8];
#pragma unroll
            for (int j = 0; j < 8; ++j) { const int key = 16 * g + 8 * (j >> 2) + 4 * hh + (j & 3); e[j] = *(const LAS unsigned short*)(lds + key * PITCH + col * 2); }
            u32x4 o; o.x = e[0] | ((unsigned)e[1] << 16); o.y = e[2] | ((unsigned)e[3] << 16); o.z = e[4] | ((unsigned)e[5] << 16); o.w = e[6] | ((unsigned)e[7] << 16);
            *(u32x4*)(VT + ((size_t)(b * NH + (col >> 6)) * 64 + (col & 63)) * LTP + k0 + 16 * g + 8 * hh) = o; }
    }
    __syncthreads();
}
__device__ __forceinline__ void ph_vt(const Params& p, int l, LAS unsigned char* lds, const int wvid) {
    const int bid = lt_bid(); unsigned char* const ws = lt_ptr(p.ws);
    const int tid = lt_tid(wvid);
    const int G_ = (int)gridDim.x;

    {   const bf16_t* U = (const bf16_t*)(ws + WS_U); unsigned* kmx = (unsigned*)(ws + WS_CTL) + CW_KMX + l * 256;
        LAS unsigned* lm = (LAS unsigned*)lds;
        for (int unit = (bid + G_ - 16) % G_; unit < NB * (LTP / 64); unit += gridDim.x) {
            const int b = unit / (LTP / 64), k0 = (unit % (LTP / 64)) * 64;
            __syncthreads();
            if (tid < 16) lm[tid] = 0u;
            __syncthreads();
            const int row = tid >> 3, g = tid & 7; const size_t ro = ((size_t)b * LT + min(k0 + row, LT - 1)) * INW;
            float n2 = 0.f, n2a = 0.f;
#pragma unroll
            for (int i = 0; i < 4; ++i) { float x[8]; load8(U + ro + C_KD + g * 32 + 8 * i, x);
#pragma unroll
                for (int e = 0; e < 8; ++e) n2 += x[e] * x[e]; }
#pragma unroll
            for (int i = 0; i < 2; ++i) { float x[8]; load8(U + ro + C_KA + g * 16 + 8 * i, x);
#pragma unroll
                for (int e = 0; e < 8; ++e) n2a += x[e] * x[e]; }
            n2a += __shfl_xor(n2a, 1); n2a += __shfl_xor(n2a, 2);
            if (k0 + row < LT) { __hip_atomic_fetch_max(lm + g, __float_as_uint(n2), __ATOMIC_RELAXED, __HIP_MEMORY_SCOPE_WORKGROUP);
                if ((g & 3) == 0) __hip_atomic_fetch_max(lm + 8 + (g >> 2), __float_as_uint(n2a), __ATOMIC_RELAXED, __HIP_MEMORY_SCOPE_WORKGROUP); }
            __syncthreads();
            if (tid < 10) __hip_atomic_fetch_max(kmx + (tid < 8 ? b * 8 + tid : 128 + b * 2 + (tid - 8)), lm[tid], __ATOMIC_RELAXED, __HIP_MEMORY_SCOPE_AGENT);
        }
        __syncthreads();
    }
}

typedef float f32x16 __attribute__((ext_vector_type(16)));
typedef float f32x2_t __attribute__((ext_vector_type(2))); typedef __bf16 bf16x2_t __attribute__((ext_vector_type(2)));
__device__ __forceinline__ unsigned pkbf(float lo, float hi) { f32x2_t v = {lo, hi}; bf16x2_t b = __builtin_convertvector(v, bf16x2_t); return __builtin_bit_cast(unsigned, b); }
__device__ __forceinline__ bf16x8 pack_acc(const f32x16& a, int s) {
    u32x4 w; w.x = pkbf(a[8 * s], a[8 * s + 1]); w.y = pkbf(a[8 * s + 2], a[8 * s + 3]); w.z = pkbf(a[8 * s + 4], a[8 * s + 5]); w.w = pkbf(a[8 * s + 6], a[8 * s + 7]);
    return __builtin_bit_cast(bf16x8, w);
}
constexpr int DF_PITCH = 144, DF_KB = 64 * DF_PITCH;
__device__ __forceinline__ void diff_tile(const bool near, const LAS unsigned char* Kb, const LAS unsigned char* Vb, const LAS float* btab, const LAS bf16x8* Qs, f32x16 (&O)[2][2],
                                          float (&lsum)[2], int qpos, int k0, int l31, int hi, float c2, float farraw) {
    float bm[2][16];
    if (near) {
#pragma unroll
        for (int kb = 0; kb < 2; ++kb)
#pragma unroll
            for (int r = 0; r < 16; ++r) { const int dist = qpos - (k0 + 32 * kb + (r & 3) + 8 * (r >> 2) + 4 * hi); bm[kb][r] = btab[min(max(dist, 0), 128)]; }
#pragma unroll
        for (int kb = 0; kb < 2; ++kb)
#pragma unroll
            for (int r = 0; r < 16; ++r) { asm volatile("" : "+v"(bm[kb][r]));
                const int dist = qpos - (k0 + 32 * kb + (r & 3) + 8 * (r >> 2) + 4 * hi); bm[kb][r] = dist < 0 ? -INFINITY : (bm[kb][r] - farraw) * c2; }
    } else {
#pragma unroll
        for (int kb = 0; kb < 2; ++kb)
#pragma unroll
            for (int r = 0; r < 16; ++r) bm[kb][r] = 0.f;
    }
    bf16x8 Vf[4][2];
#pragma unroll
    for (int st = 0; st < 4; ++st)
#pragma unroll
        for (int dvb = 0; dvb < 2; ++dvb) Vf[st][dvb] = *(const LAS bf16x8*)(Vb + (32 * dvb + l31) * DF_PITCH + st * 32 + hi * 16);
    u32x4 kxw; kxw.x = hi ? 0u : 0x3F80u; kxw.y = 0u; kxw.z = 0u; kxw.w = 0u;
    const bf16x8 kx = __builtin_bit_cast(bf16x8, kxw);
#pragma unroll
    for (int c = 0; c < 2; ++c) {
        f32x16 S[2];
#pragma unroll
        for (int kb = 0; kb < 2; ++kb) {
            f32x16 acc;
#pragma unroll
            for (int r = 0; r < 16; ++r) acc[r] = 0.f;
#pragma unroll
            for (int s = 0; s < 2; ++s) { const bf16x8 kf = *(const LAS bf16x8*)(Kb + (32 * kb + l31) * DF_PITCH + c * 64 + s * 32 + hi * 16);
                acc = __builtin_amdgcn_mfma_f32_32x32x16_bf16(kf, Qs[(c * 2 + s) * 64], acc, 0, 0, 0); }
            acc = __builtin_amdgcn_mfma_f32_32x32x16_bf16(kx, Qs[(4 + c) * 64], acc, 0, 0, 0);
            S[kb] = acc;
        }
        if (near) {
#pragma unroll
            for (int kb = 0; kb < 2; ++kb)
#pragma unroll
                for (int r = 0; r < 16; ++r) S[kb][r] += bm[kb][r]; }
        float ls = 0.f;
        bf16x8 Pf[4];
#pragma unroll
        for (int kb = 0; kb < 2; ++kb) {
#pragma unroll
            for (int r = 0; r < 16; ++r) { const float pv = __builtin_amdgcn_exp2f(S[kb][r]); ls += pv; S[kb][r] = pv; }
#pragma unroll
            for (int s = 0; s < 2; ++s) Pf[2 * kb + s] = pack_acc(S[kb], s);
        }
        lsum[c] += ls;
#pragma unroll
        for (int st = 0; st < 4; ++st)
#pragma unroll
            for (int dvb = 0; dvb < 2; ++dvb) O[c][dvb] = __builtin_amdgcn_mfma_f32_32x32x16_bf16(Vf[st][dvb], Pf[st], O[c][dvb], 0, 0, 0);
    }
}
__device__ __forceinline__ void ph_diff2(const Params& p, int l, LAS unsigned char* lds, const int wvid, const int qslot = 0) {
    const int bid = lt_bid(); unsigned char* const ws = lt_ptr(p.ws); (void)bid;
    const int tid = lt_tid(wvid), lane = tid & 63, wave = __builtin_amdgcn_readfirstlane(tid >> 6), l31 = lane & 31, hi = lane >> 5;
    const bf16_t* U = (const bf16_t*)(ws + WS_U); const bf16_t* VT = (const bf16_t*)(ws + WS_VTD); bf16_t* MIX = (bf16_t*)(ws + WS_MIX);
    unsigned* qhead = (unsigned*)(ws + WS_CTL) + CW_DQ + (qslot * 4 + l) * 64;
    LAS float* btab = (LAS float*)lds;
    LAS int* ucur = (LAS int*)(lds + 4 * 132 * 4);
    LAS unsigned char* KV = lds + 4096;
    constexpr float LOG2E = 1.4426950408889634f;
    for (int i = tid; i < 4 * 129; i += NTHR) { const int h = i / 129, n = i % 129; btab[h * 132 + n] = p.in[I_RELB][t5_bucket(n) * 8 + 4 + h] * 5.656854249492381f; }
    if (tid < 4) { float bx = -1e30f; for (int n = 0; n < 32; ++n) bx = fmaxf(bx, p.in[I_RELB][n * 8 + 4 + tid]); btab[tid * 132 + 129] = bx * 5.656854249492381f; }
    float s1 = 0.f, s2 = 0.f;
    for (int i = 0; i < 32; ++i) { s1 += p.in[I_LQ1][l * 32 + i] * p.in[I_LK1][l * 32 + i]; s2 += p.in[I_LQ2][l * 32 + i] * p.in[I_LK2][l * 32 + i]; }
    const float lam_init = 0.8f - 0.6f * expf(-0.3f * (float)l), lam = expf(s1) - expf(s2) + lam_init;
    const float c2 = 0.17677669529663687f * LOG2E;
    const int krow = tid >> 3, kch = tid & 7;
    for (;;) {
        __syncthreads();
        if (tid == 0) *ucur = (int)atomicAdd(qhead, 1u);
        __syncthreads();
        const int u = *ucur;
        if (u >= 17 * 32) break;
        const int qi = 16 - u / 32, bh = u % 32, b = bh >> 2, h = bh & 3;
        const int q0 = qi == 0 ? 0 : 16 + 256 * (qi - 1), nkt = qi == 0 ? 1 : 4 * qi + 1;
        const int q0w = q0 + 32 * wave, qpos = q0w + l31;
        const bool wave_on = (qi > 0) || (wave == 0);
        const size_t qrow = (size_t)b * LT + (qpos < LT ? qpos : LT - 1);
        LAS bf16x8* Qs = (LAS bf16x8*)(lds + 4096 + 4 * DF_KB) + wave * 384 + lane;
        const float farb = btab[h * 132 + 128] * c2;
        float mref[2];
        { const unsigned* kmx = (const unsigned*)(ws + WS_CTL) + CW_KMX + l * 256 + b * 8 + h * 2;
#pragma unroll
          for (int c = 0; c < 2; ++c) { float qn2 = 0.f;
#pragma unroll
              for (int s = 0; s < 2; ++s) { const u32x4 qv = *(const u32x4*)(U + qrow * INW + C_QD + h * 64 + c * 32 + s * 16 + hi * 8);
                  const unsigned qw[4] = {qv.x, qv.y, qv.z, qv.w};
                  { u32x4 qs; qs.x = pkbf(bflo(qw[0]) * c2, bfhi(qw[0]) * c2); qs.y = pkbf(bflo(qw[1]) * c2, bfhi(qw[1]) * c2); qs.z = pkbf(bflo(qw[2]) * c2, bfhi(qw[2]) * c2); qs.w = pkbf(bflo(qw[3]) * c2, bfhi(qw[3]) * c2);
                    Qs[(c * 2 + s) * 64] = __builtin_bit_cast(bf16x8, qs); }
#pragma unroll
                  for (int e = 0; e < 4; ++e) qn2 += bflo(qw[e]) * bflo(qw[e]) + bfhi(qw[e]) * bfhi(qw[e]); }
              qn2 += __shfl_xor(qn2, 32);
              const float km2 = __uint_as_float(__hip_atomic_load(kmx + c, __ATOMIC_RELAXED, __HIP_MEMORY_SCOPE_AGENT));
              mref[c] = (sqrtf(qn2 * km2) * 1.001f + btab[h * 132 + 129]) * c2;
              { u32x4 qx; qx.x = hi ? 0u : (pkbf(farb - mref[c], 0.f) & 0xffffu); qx.y = 0u; qx.z = 0u; qx.w = 0u; Qs[(4 + c) * 64] = __builtin_bit_cast(bf16x8, qx); } } }
        f32x16 O[2][2]; float lsum[2] = {0.f, 0.f};
#pragma unroll
        for (int c = 0; c < 2; ++c)
#pragma unroll
            for (int d = 0; d < 2; ++d)
#pragma unroll
                for (int r = 0; r < 16; ++r) O[c][d][r] = 0.f;
        const bf16_t* kbase = U + (size_t)b * LT * INW + C_KD + h * 64;
        const bf16_t* vbase = VT + (size_t)bh * 64 * LTP;
        const unsigned koff = (unsigned)(krow * INW + kch * 8), voff = (unsigned)(krow * LTP + kch * 8);
        const float farraw = btab[h * 132 + 128];
        u32x4 kreg = *(const u32x4*)(kbase + koff), vreg = *(const u32x4*)(vbase + voff);
        *(LAS u32x4*)(KV + krow * DF_PITCH + kch * 16) = kreg; *(LAS u32x4*)(KV + 2 * DF_KB + krow * DF_PITCH + kch * 16) = vreg;
        __syncthreads();
        for (int kt = 0; kt < nkt; ++kt) {
            const int k0 = kt * 64, cur = kt & 1;
            if (kt + 1 < nkt) { kreg = *(const u32x4*)(kbase + (koff + (unsigned)((k0 + 64) * INW))); vreg = *(const u32x4*)(vbase + (voff + (unsigned)(k0 + 64))); }
            if (wave_on && k0 <= q0w + 31) {
                const LAS unsigned char* Kb = KV + cur * DF_KB; const LAS unsigned char* Vb = KV + (2 + cur) * DF_KB;
                diff_tile(q0w - (k0 + 63) < 113, Kb, Vb, btab + h * 132, Qs, O, lsum, qpos, k0, l31, hi, c2, farraw);
            }
            if (kt + 1 < nkt) { *(LAS u32x4*)(KV + (cur ^ 1) * DF_KB + krow * DF_PITCH + kch * 16) = kreg; *(LAS u32x4*)(KV + (2 + (cur ^ 1)) * DF_KB + krow * DF_PITCH + kch * 16) = vreg; }
            __syncthreads();
        }
        const float l0 = lsum[0] + __shfl_xor(lsum[0], 32), l1 = lsum[1] + __shfl_xor(lsum[1], 32);
        const float i0 = 1.0f / l0, i1 = lam / l1;
        float ss = 0.f;
#pragma unroll
        for (int d = 0; d < 2; ++d)
#pragma unroll
            for (int r = 0; r < 16; ++r) { const float o = O[0][d][r] * i0 - O[1][d][r] * i1; O[0][d][r] = o; ss += o * o; }
        ss += __shfl_xor(ss, 32);
        const float rn = frsq(ss * (1.f / 64.f) + 1e-5f) * (1.0f - lam_init);
        const int lane2 = lt_tid(wvid) & 63, qpos2 = q0w + (lane2 & 31), hi2 = lane2 >> 5;
        if (wave_on && qpos2 < LT && (qi > 0 || qpos2 < NMETA)) {
            bf16_t* orow = MIX + ((size_t)b * LT + qpos2) * D + M_B + h * 64;
#pragma unroll
            for (int d = 0; d < 2; ++d)
#pragma unroll
                for (int g4 = 0; g4 < 4; ++g4) { const int dv0 = 32 * d + 8 * g4 + 4 * hi2; const f32x4 gg = *(const f32x4*)(p.in[I_SUBLN] + l * 64 + dv0);
                    u32x2 w; w.x = pkbf(O[0][d][4 * g4] * rn * gg[0], O[0][d][4 * g4 + 1] * rn * gg[1]); w.y = pkbf(O[0][d][4 * g4 + 2] * rn * gg[2], O[0][d][4 * g4 + 3] * rn * gg[3]);
                    *(u32x2*)(orow + dv0) = w; }
        }
    }
    __syncthreads();
}


__device__ __forceinline__ void swa_tile(const LAS unsigned char* Kb, const LAS unsigned char* Vb, const LAS float* btab, const bf16x8 (&Qf)[4], const bf16x8 qx, f32x16 (&O)[2],
                                         float& lsum, int qpos, int k0, int l31, int hi) {
    u32x4 kxw; kxw.x = hi ? 0u : 0x3F80u; kxw.y = 0u; kxw.z = 0u; kxw.w = 0u;
    const bf16x8 kx = __builtin_bit_cast(bf16x8, kxw);
    f32x16 S[2];
#pragma unroll
    for (int kb = 0; kb < 2; ++kb) {
        f32x16 acc;
#pragma unroll
        for (int r = 0; r < 16; ++r) acc[r] = 0.f;
#pragma unroll
        for (int s = 0; s < 4; ++s) { const bf16x8 kf = *(const LAS bf16x8*)(Kb + (32 * kb + l31) * DF_PITCH + s * 32 + hi * 16);
            acc = __builtin_amdgcn_mfma_f32_32x32x16_bf16(kf, Qf[s], acc, 0, 0, 0); }
        acc = __builtin_amdgcn_mfma_f32_32x32x16_bf16(kx, qx, acc, 0, 0, 0);
        S[kb] = acc;
    }
    float ls = 0.f;
    bf16x8 Pf[4];
#pragma unroll
    for (int kb = 0; kb < 2; ++kb) {
#pragma unroll
        for (int r = 0; r < 16; ++r) { const int j = k0 + 32 * kb + (r & 3) + 8 * (r >> 2) + 4 * hi, dist = qpos - j;
            const LAS float* tb = (k0 == 0 && kb == 0 && r < 8) ? btab + 4 * 132 : btab;
            const float pv = __builtin_amdgcn_exp2f(S[kb][r] + tb[min(max(dist + 1, 0), 129)]); ls += pv; S[kb][r] = pv; }
#pragma unroll
        for (int s = 0; s < 2; ++s) Pf[2 * kb + s] = pack_acc(S[kb], s);
    }
    lsum += ls;
#pragma unroll
    for (int st = 0; st < 4; ++st) { asm volatile("" ::: "memory");
#pragma unroll
        for (int dvb = 0; dvb < 2; ++dvb) { const bf16x8 vf = *(const LAS bf16x8*)(Vb + (32 * dvb + l31) * DF_PITCH + st * 32 + hi * 16);
            O[dvb] = __builtin_amdgcn_mfma_f32_32x32x16_bf16(vf, Pf[st], O[dvb], 0, 0, 0); } }
    asm volatile("" ::: "memory");
}
__device__ __forceinline__ void ph_swa2(const Params& p, int l, LAS unsigned char* lds, const int wvid, const int qslot = 0) {
    const int bid = lt_bid(); unsigned char* const ws = lt_ptr(p.ws); (void)bid;
    const int tid = lt_tid(wvid), lane = tid & 63, wave = __builtin_amdgcn_readfirstlane(tid >> 6), l31 = lane & 31, hi = lane >> 5;
    const bf16_t* U = (const bf16_t*)(ws + WS_U); const bf16_t* VT = (const bf16_t*)(ws + WS_VTA); bf16_t* MIX = (bf16_t*)(ws + WS_MIX);
    unsigned* qhead = (unsigned*)(ws + WS_CTL) + CW_DQ + (qslot * 4 + 2 + l) * 64;
    LAS float* btab = (LAS float*)lds;
    LAS int* ucur = (LAS int*)(lds + 8 * 132 * 4);
    LAS unsigned char* KV = lds + 8192;
    constexpr float LOG2E = 1.4426950408889634f;
    __syncthreads();
    const float c2 = 0.125f * LOG2E;
    for (int i = tid; i < 4 * 130; i += NTHR) { const int h = i / 130, n = i % 130;
        const float bv = n == 0 ? -INFINITY : p.in[I_RELB][t5_bucket(min(n - 1, 128)) * 8 + h] * LOG2E;
        btab[h * 132 + n] = n == 129 ? -INFINITY : bv; btab[(4 + h) * 132 + n] = bv; }
    if (tid < 4) { float bx = -1e30f; for (int n = 0; n < 32; ++n) bx = fmaxf(bx, p.in[I_RELB][n * 8 + tid]); btab[tid * 132 + 131] = bx * LOG2E; }
    const int krow = tid >> 3, kch = tid & 7;
    for (;;) {
        __syncthreads();
        if (tid == 0) *ucur = (int)atomicAdd(qhead, 1u);
        __syncthreads();
        const int u = *ucur;
        if (u >= 33 * 16) break;
        const int qi = 32 - u / 16, bk = u % 16, b = bk >> 1, hkv = bk & 1, hq = 2 * hkv + (wave >> 2);
        const int q0 = qi == 0 ? 0 : 16 + 128 * (qi - 1);
        const int ktlo = max(1, (q0 - 127) / 64), kthi = qi == 0 ? 0 : (q0 + 127) / 64;
        const int ntile = 1 + (kthi >= ktlo ? kthi - ktlo + 1 : 0);
        const int q0w = q0 + 32 * (wave & 3), qpos = q0w + l31;
        const bool wave_on = (qi > 0) || ((wave & 3) == 0);
        const size_t qrow = (size_t)b * LT + (qpos < LT ? qpos : LT - 1);
        bf16x8 Qf[4]; bf16x8 qx; float lsum;
        { u32x4 qraw[4]; float qn2 = 0.f;
#pragma unroll
          for (int s = 0; s < 4; ++s) qraw[s] = *(const u32x4*)(U + qrow * INW + C_QA + hq * 64 + s * 16 + hi * 8);
          const float km2 = __uint_as_float(__hip_atomic_load((const unsigned*)(ws + WS_CTL) + CW_KMX + l * 256 + 128 + b * 2 + hkv, __ATOMIC_RELAXED, __HIP_MEMORY_SCOPE_AGENT));
#pragma unroll
          for (int s = 0; s < 4; ++s) { const unsigned qw[4] = {qraw[s].x, qraw[s].y, qraw[s].z, qraw[s].w}; u32x4 qs;
#pragma unroll
              for (int e = 0; e < 4; ++e) qn2 += bflo(qw[e]) * bflo(qw[e]) + bfhi(qw[e]) * bfhi(qw[e]);
              qs.x = pkbf(bflo(qw[0]) * c2, bfhi(qw[0]) * c2); qs.y = pkbf(bflo(qw[1]) * c2, bfhi(qw[1]) * c2); qs.z = pkbf(bflo(qw[2]) * c2, bfhi(qw[2]) * c2); qs.w = pkbf(bflo(qw[3]) * c2, bfhi(qw[3]) * c2);
              Qf[s] = __builtin_bit_cast(bf16x8, qs); }
          qn2 += __shfl_xor(qn2, 32);
          const float snk = p.in[I_SINKS][l * 4 + hq] * LOG2E;
          const float mref = fmaxf(sqrtf(qn2 * km2) * 1.001f * c2 + btab[hq * 132 + 131], snk);
          u32x4 qxw; qxw.x = hi ? 0u : (pkbf(-mref, 0.f) & 0xffffu); qxw.y = 0u; qxw.z = 0u; qxw.w = 0u; qx = __builtin_bit_cast(bf16x8, qxw);
          const float mrb = bflo(pkbf(-mref, 0.f));
          lsum = hi == 0 ? __builtin_amdgcn_exp2f(snk + mrb) : 0.0f; }
        f32x16 O[2];
#pragma unroll
        for (int d = 0; d < 2; ++d)
#pragma unroll
            for (int r = 0; r < 16; ++r) O[d][r] = 0.f;
        const bf16_t* kbase = U + (size_t)b * LT * INW + C_KA + hkv * 64;
        const bf16_t* vbase = VT + (size_t)bk * 64 * LTP;
        const unsigned koff = (unsigned)(krow * INW + kch * 8), voff = (unsigned)(krow * LTP + kch * 8);
        u32x4 kreg = *(const u32x4*)(kbase + koff), vreg = *(const u32x4*)(vbase + voff);
        *(LAS u32x4*)(KV + krow * DF_PITCH + kch * 16) = kreg; *(LAS u32x4*)(KV + 2 * DF_KB + krow * DF_PITCH + kch * 16) = vreg;
        __syncthreads();
        for (int ti = 0; ti < ntile; ++ti) {
            const int kt = ti == 0 ? 0 : ktlo + ti - 1, k0 = kt * 64, cur = ti & 1;
            if (ti + 1 < ntile) { const int kn = (ktlo + ti) * 64; kreg = *(const u32x4*)(kbase + (koff + (unsigned)(kn * INW))); vreg = *(const u32x4*)(vbase + (voff + (unsigned)kn)); }
            if (wave_on && (kt == 0 || (k0 <= q0w + 31 && k0 + 63 >= q0w - 127)))
                swa_tile(KV + cur * DF_KB, KV + (2 + cur) * DF_KB, btab + hq * 132, Qf, qx, O, lsum, qpos, k0, l31, hi);
            if (ti + 1 < ntile) { *(LAS u32x4*)(KV + (cur ^ 1) * DF_KB + krow * DF_PITCH + kch * 16) = kreg; *(LAS u32x4*)(KV + (2 + (cur ^ 1)) * DF_KB + krow * DF_PITCH + kch * 16) = vreg; }
            __syncthreads();
        }
        const float lt = lsum + __shfl_xor(lsum, 32), inv = 1.0f / lt;
        const int lane2 = lt_tid(wvid) & 63, qpos2 = q0w + (lane2 & 31), hi2 = lane2 >> 5;
        if (wave_on && qpos2 < LT && (qi > 0 || qpos2 < NMETA)) {
            bf16_t* orow = MIX + ((size_t)b * LT + qpos2) * D + M_A + hq * 64;
#pragma unroll
            for (int d = 0; d < 2; ++d)
#pragma unroll
                for (int g4 = 0; g4 < 4; ++g4) { const int dv0 = 32 * d + 8 * g4 + 4 * hi2;
                    u32x2 w; w.x = pkbf(O[d][4 * g4] * inv, O[d][4 * g4 + 1] * inv); w.y = pkbf(O[d][4 * g4 + 2] * inv, O[d][4 * g4 + 3] * inv);
                    *(u32x2*)(orow + dv0) = w; }
        }
    }
    __syncthreads();
}

__device__ __forceinline__ void ph_conv2(const Params& p, int l, LAS unsigned char* lds, const int wvid) {
    const int bid = lt_bid(); unsigned char* const ws = lt_ptr(p.ws);
    const int tid = lt_tid(wvid), c = tid & 255, th = tid >> 8;
    const bf16_t* U = (const bf16_t*)(ws + WS_U); bf16_t* MIX = (bf16_t*)(ws + WS_MIX);
    LAS float* G = (LAS float*)lds;
    const float* cw = p.in[I_CONVW] + (size_t)l * 31 * 256; const float cb = p.in[I_CONVB][l * 256 + c], gg = p.in[I_GNG][l * 256 + c], gb = p.in[I_GNB][l * 256 + c];
    float wv[31];
#pragma unroll
    for (int w = 0; w < 31; ++w) wv[w] = cw[w * 256 + c];
    const bool bal = (int)gridDim.x == 256;
    const int nkk = bal ? 3 : (NB * 64 + (int)gridDim.x - 1) / (int)gridDim.x;
    for (int kk = 0; kk < nkk; ++kk) {
        int unit;
        if (!bal) unit = bid + kk * (int)gridDim.x;
        else if (kk < 2) unit = (bid >= 32 && bid < 40) ? NB * 64 : bid + 256 * kk;
        else unit = (bid >= 40 && bid < 56) ? (bid < 48 ? bid - 8 : bid + 240) : NB * 64;
        if (unit >= NB * 64) continue;
        const int b = unit >> 6, t0 = (unit & 63) * 64, ntok = (unit & 63) == 63 ? 80 : 64, nrow = ntok + 30;
        __syncthreads();
        { u32x4 av[7], gv[7];
#pragma unroll
          for (int q = 0; q < 7; ++q) { const int it = tid + q * NTHR, row = it >> 5, ch = it & 31, tt = t0 - 30 + row;
              const bf16_t* ur = U + ((size_t)b * LT + min(max(tt, 0), LT - 1)) * INW; av[q] = *(const u32x4*)(ur + C_CA + ch * 8); gv[q] = *(const u32x4*)(ur + C_CG + ch * 8);
              if (tt < 0 || tt >= LT) av[q] = (u32x4){0u, 0u, 0u, 0u}; }
#pragma unroll
          for (int q = 0; q < 7; ++q) { const int it = tid + q * NTHR, row = it >> 5, ch = it & 31;
              if (row < nrow) { float o[8];
                  const unsigned aw_[4] = {av[q].x, av[q].y, av[q].z, av[q].w}, gw_[4] = {gv[q].x, gv[q].y, gv[q].z, gv[q].w};
#pragma unroll
                  for (int e = 0; e < 4; ++e) { o[2 * e] = bflo(aw_[e]) * sigmoidf_(bflo(gw_[e])); o[2 * e + 1] = bfhi(aw_[e]) * sigmoidf_(bfhi(gw_[e])); }
                  *(LAS f32x4*)(G + row * 256 + ch * 8) = (f32x4){o[0], o[1], o[2], o[3]}; *(LAS f32x4*)(G + row * 256 + ch * 8 + 4) = (f32x4){o[4], o[5], o[6], o[7]}; } } }
        __syncthreads();
#pragma unroll 1
        for (int tb = 0; tb < (ntok >> 4); ++tb) {
            const int tl = th * (ntok >> 1) + tb * 8;
            float x[38];
#pragma unroll
            for (int i = 0; i < 38; ++i) x[i] = G[(tl + i) * 256 + c];
#pragma unroll
            for (int o = 0; o < 8; ++o) { float acc = cb;
#pragma unroll
                for (int w = 0; w < 31; ++w) acc += wv[w] * x[o + w];
                const float mean = wave_sum(acc) * (1.f / 64.f); const float dv = acc - mean; const float var = wave_sum(dv * dv) * (1.f / 64.f);
                const float y = dv * frsq(var + 1e-5f) * gg + gb;
                const int tg = t0 + tl + o;
                if (tg < LT) MIX[((size_t)b * LT + tg) * D + M_D + c] = f2bf(y * sigmoidf_(y)); }
        }
    }
    __syncthreads();
}

__device__ __forceinline__ int kperm(int k) { return (k & ~12) | ((k & 4) << 1) | ((k & 8) >> 1); }

constexpr int R1_XSP = 776, R1_XLP = 264;
__device__ __forceinline__ float scan32(float v) {
    v = dpp_add<0x111, 0xF>(v); v = dpp_add<0x112, 0xF>(v); v = dpp_add<0x114, 0xF>(v); v = dpp_add<0x118, 0xF>(v); v = dpp_add<0x142, 0xA>(v); return v;
}
__device__ __forceinline__ float fast_tanh(float x) { const float t = __expf(2.0f * x); return 1.0f - 2.0f * frcp(1.0f + t); }
__device__ __forceinline__ u32x4 pair16(u32x2 a, u32x2 b) {
    const auto rx = __builtin_amdgcn_permlane32_swap(a.x, b.x, false, false); const auto ry = __builtin_amdgcn_permlane32_swap(a.y, b.y, false, false);
    return (u32x4){rx[0], ry[0], rx[1], ry[1]};
}
__device__ __forceinline__ void ph_rwkv_prep2(const Params& p, int l, LAS unsigned char* lds, const int wvid) {
    const int bid = lt_bid(); unsigned char* const ws = lt_ptr(p.ws); unsigned char* const ob = lt_ptr((unsigned char*)p.out);
    const int wave = __builtin_amdgcn_readfirstlane(lt_tid(wvid) >> 6), h = wave >> 1, tb = wave & 1;
    const bf16_t* U = (const bf16_t*)(ws + WS_U);
    const bf16_t* LW = (const bf16_t*)(ws + WS_LORA) + (size_t)l * 65536;
    LAS bf16_t* XS = (LAS bf16_t*)lds; LAS bf16_t* XL = (LAS bf16_t*)(lds + 64 * R1_XSP * 2); LAS float* TOT = (LAS float*)(lds + 64 * R1_XSP * 2 + 64 * R1_XLP * 2);
    LAS float* PAR = TOT + 256;
    bf16_t* ATg = (bf16_t*)(ob + RO_AT); bf16_t* BTg = (bf16_t*)(ob + RO_BT); bf16_t* KTg = (bf16_t*)(ob + RO_KT); bf16_t* RTg = (bf16_t*)(ob + RO_RT); bf16_t* VVg = (bf16_t*)(ob + RO_VV);
    bf16_t* Gg = (bf16_t*)(ws + WS_RWB + RW_G); float* BCg = (float*)(ws + WS_RWB + RW_BC); float* GCg = (float*)(ws + WS_RWB + RW_GC);
    const float* mu = p.in[I_MU] + l * 1024;
    __syncthreads();
    { const int t_ = lt_tid(wvid); if (t_ < 256) { PAR[t_] = p.in[I_W0][l * 256 + t_]; PAR[256 + t_] = p.in[I_A0][l * 256 + t_]; PAR[512 + t_] = p.in[I_KK][l * 256 + t_]; PAR[768 + t_] = p.in[I_KA][l * 256 + t_]; PAR[1024 + t_] = p.in[I_RK][l * 256 + t_]; } }
    for (int unit = (bid + (int)gridDim.x - 32) % (int)gridDim.x; unit < NB * RCH; unit += gridDim.x) {
        const int b = unit / RCH, ch = unit % RCH, t0 = ch * 64;
        const int tid = lt_tid(wvid), lane = tid & 63, l31 = lane & 31, hi = lane >> 5;
        __syncthreads();
        { const int col0 = (tid & 127) * 8, trow = tid >> 7;
          const f32x4 m0 = *(const f32x4*)(mu + col0), m1 = *(const f32x4*)(mu + col0 + 4);
          u32x4 cu[17];
          const bf16_t* ub = U + (size_t)b * LT * INW + C_RW + col0;
#pragma unroll
          for (int q = 0; q < 17; ++q) { const int tg = t0 + 16 * trow + q - 1; cu[q] = *(const u32x4*)(ub + (size_t)min(max(tg, 0), LT - 1) * INW); }
#pragma unroll
          for (int q = 0; q < 17; ++q) { const int tg = t0 + 16 * trow + q - 1; const u32x4 z = (u32x4){0u, 0u, 0u, 0u}; if (tg >= LT || tg < 0) cu[q] = z; }
#pragma unroll
          for (int q = 0; q < 16; ++q) { const int t = 16 * trow + q;
              const u32x4 pq = (t0 + t >= LT) ? (u32x4){0u, 0u, 0u, 0u} : cu[q];
              const unsigned cw_[4] = {cu[q + 1].x, cu[q + 1].y, cu[q + 1].z, cu[q + 1].w}, pw_[4] = {pq.x, pq.y, pq.z, pq.w}; float x[8];
#pragma unroll
              for (int e = 0; e < 4; ++e) { const float c0 = bflo(cw_[e]), c1 = bfhi(cw_[e]); const float ml = e < 2 ? m0[2 * e] : m1[2 * e - 4], mh = e < 2 ? m0[2 * e + 1] : m1[2 * e - 3];
                  x[2 * e] = c0 + ml * (bflo(pw_[e]) - c0); x[2 * e + 1] = c1 + mh * (bfhi(pw_[e]) - c1); }
              u32x4 w; w.x = pkbf(x[0], x[1]); w.y = pkbf(x[2], x[3]); w.z = pkbf(x[4], x[5]); w.w = pkbf(x[6], x[7]);
              if (col0 < 768) *(LAS u32x4*)(XS + t * R1_XSP + col0) = w; else *(LAS u32x4*)(XL + t * R1_XLP + (col0 - 768)) = w; } }
        __syncthreads();
        { const int row = tid >> 3, sub = tid & 7;
          LAS u32x4* pw = (LAS u32x4*)(XL + row * R1_XLP + 8 * sub); LAS u32x4* pg = (LAS u32x4*)(XL + row * R1_XLP + 128 + 16 * sub);
          u32x4 w = pw[0], g0 = pg[0], g1 = pg[1];
          unsigned a_[4] = {w.x, w.y, w.z, w.w}, b_[4] = {g0.x, g0.y, g0.z, g0.w}, c_[4] = {g1.x, g1.y, g1.z, g1.w};
#pragma unroll
          for (int e = 0; e < 4; ++e) { a_[e] = pkbf(fast_tanh(bflo(a_[e])), fast_tanh(bfhi(a_[e]))); b_[e] = pkbf(sigmoidf_(bflo(b_[e])), sigmoidf_(bfhi(b_[e]))); c_[e] = pkbf(sigmoidf_(bflo(c_[e])), sigmoidf_(bfhi(c_[e]))); }
          w.x = a_[0]; w.y = a_[1]; w.z = a_[2]; w.w = a_[3]; g0.x = b_[0]; g0.y = b_[1]; g0.z = b_[2]; g0.w = b_[3]; g1.x = c_[0]; g1.y = c_[1]; g1.z = c_[2]; g1.w = c_[3];
          pw[0] = w; pg[0] = g0; pg[1] = g1; }
        __syncthreads();
        f32x16 aw[2], aa[2], ag[2];
#pragma unroll
        for (int cb = 0; cb < 2; ++cb)
#pragma unroll
            for (int r = 0; r < 16; ++r) { aw[cb][r] = 0.f; aa[cb][r] = 0.f; ag[cb][r] = 0.f; }
        const LAS bf16_t* xrow = XL + (32 * tb + l31) * R1_XLP + 8 * hi;
        {
            bf16x8 wf[4][2], af[4][2];
#pragma unroll
            for (int ks = 0; ks < 4; ++ks)
#pragma unroll
                for (int cb = 0; cb < 2; ++cb) { const int c = 64 * h + 32 * cb + l31; wf[ks][cb] = *(const bf16x8*)(LW + ks * 4096 + c * 16 + 8 * hi); af[ks][cb] = *(const bf16x8*)(LW + 16384 + ks * 4096 + c * 16 + 8 * hi); }
            asm volatile("" ::: "memory");
#pragma unroll
            for (int ks = 0; ks < 4; ++ks) { const bf16x8 fw = *(const LAS bf16x8*)(xrow + 16 * ks), fa = *(const LAS bf16x8*)(xrow + 64 + 16 * ks);
#pragma unroll
                for (int cb = 0; cb < 2; ++cb) { aw[cb] = __builtin_amdgcn_mfma_f32_32x32x16_bf16(wf[ks][cb], fw, aw[cb], 0, 0, 0); aa[cb] = __builtin_amdgcn_mfma_f32_32x32x16_bf16(af[ks][cb], fa, aa[cb], 0, 0, 0); } }
        }
        {
            bf16x8 gf[8][2];
#pragma unroll
            for (int ks = 0; ks < 8; ++ks)
#pragma unroll
                for (int cb = 0; cb < 2; ++cb) { const int c = 64 * h + 32 * cb + l31; gf[ks][cb] = *(const bf16x8*)(LW + 32768 + ks * 4096 + c * 16 + 8 * hi); }
            asm volatile("" ::: "memory");
#pragma unroll
            for (int ks = 0; ks < 8; ++ks) { const bf16x8 fg = *(const LAS bf16x8*)(xrow + 128 + 16 * ks);
#pragma unroll
                for (int cb = 0; cb < 2; ++cb) ag[cb] = __builtin_amdgcn_mfma_f32_32x32x16_bf16(gf[ks][cb], fg, ag[cb], 0, 0, 0); }
        }
        const int t = 32 * tb + l31, tg = t0 + t; const bool ok = tg < LT; const size_t row = (size_t)b * LT + (ok ? tg : LT - 1);
        {
#pragma unroll
            for (int cb = 0; cb < 2; ++cb)
#pragma unroll
                for (int qp = 0; qp < 2; ++qp) { u32x2 w[2];
#pragma unroll
                    for (int qq = 0; qq < 2; ++qq) { const int q = 2 * qp + qq; w[qq].x = pkbf(ag[cb][4 * q], ag[cb][4 * q + 1]); w[qq].y = pkbf(ag[cb][4 * q + 2], ag[cb][4 * q + 3]); }
                    const u32x4 pg = pair16(w[0], w[1]);
                    if (ok) *(u32x4*)(Gg + row * 256 + 64 * h + 32 * cb + 16 * qp + 8 * hi) = pg; } }
        float cum[2][16];
#pragma unroll
        for (int cb = 0; cb < 2; ++cb)
#pragma unroll
            for (int q = 0; q < 4; ++q) { const int c0 = 64 * h + 32 * cb + 8 * q + 4 * hi; const f32x4 w0 = *(const LAS f32x4*)(PAR + c0), a0 = *(const LAS f32x4*)(PAR + 256 + c0);
#pragma unroll
                for (int i = 0; i < 4; ++i) { const int r = 4 * q + i; const float lw = ok ? -0.6065306597126334f * sigmoidf_(w0[i] + aw[cb][r]) : 0.f; aw[cb][r] = lw; cum[cb][r] = scan32(lw);
                    aa[cb][r] = sigmoidf_(a0[i] + aa[cb][r]); } }
        if (tb == 0 && l31 == 31) {
#pragma unroll
            for (int cb = 0; cb < 2; ++cb)
#pragma unroll
                for (int q = 0; q < 4; ++q) *(LAS f32x4*)(TOT + 64 * h + 32 * cb + 8 * q + 4 * hi) = (f32x4){cum[cb][4 * q], cum[cb][4 * q + 1], cum[cb][4 * q + 2], cum[cb][4 * q + 3]}; }
        __syncthreads();
        if (tb == 1) {
#pragma unroll
            for (int cb = 0; cb < 2; ++cb)
#pragma unroll
                for (int q = 0; q < 4; ++q) { const f32x4 t0s = *(const LAS f32x4*)(TOT + 64 * h + 32 * cb + 8 * q + 4 * hi);
#pragma unroll
                    for (int i = 0; i < 4; ++i) cum[cb][4 * q + i] += t0s[i];
                    if (l31 == 31) *(f32x4*)(GCg + ((size_t)(b * 4 + h) * RCH + ch) * 64 + 32 * cb + 8 * q + 4 * hi) =
                        (f32x4){__expf(cum[cb][4 * q]), __expf(cum[cb][4 * q + 1]), __expf(cum[cb][4 * q + 2]), __expf(cum[cb][4 * q + 3])}; } }
        const LAS bf16_t* xs = XS + t * R1_XSP + 64 * h + 4 * hi;
        float n2 = 0.f, bc = 0.f;
#pragma unroll
        for (int cb = 0; cb < 2; ++cb)
#pragma unroll
            for (int q = 0; q < 4; ++q) { const int c0 = 64 * h + 32 * cb + 8 * q + 4 * hi; const int xo = 32 * cb + 8 * q;
                const u32x2 r2 = *(const LAS u32x2*)(xs + xo), k2 = *(const LAS u32x2*)(xs + 256 + xo);
                const f32x4 kkp = *(const LAS f32x4*)(PAR + 512 + c0), kap = *(const LAS f32x4*)(PAR + 768 + c0), rk = *(const LAS f32x4*)(PAR + 1024 + c0);
                const float rr[4] = {bflo(r2.x), bfhi(r2.x), bflo(r2.y), bfhi(r2.y)}, kr[4] = {bflo(k2.x), bfhi(k2.x), bflo(k2.y), bfhi(k2.y)};
#pragma unroll
                for (int i = 0; i < 4; ++i) { const float kkr = kr[i] * kkp[i], km = kr[i] * (1.0f + (aa[cb][4 * q + i] - 1.0f) * kap[i]); n2 += kkr * kkr; bc += rr[i] * km * rk[i]; } }
        n2 += __shfl_xor(n2, 32); bc += __shfl_xor(bc, 32);
        if (ok && hi == 0) BCg[row * 4 + h] = bc;
        const float rn = frsq(fmaxf(n2, 1e-24f));
        const size_t obase = ((size_t)(b * 4 + h) * RCH + ch) * 4096;
#pragma unroll
        for (int cb = 0; cb < 2; ++cb)
#pragma unroll
            for (int qp = 0; qp < 2; ++qp) { u32x2 wa[2], wb[2], wk[2], wr[2], wv[2];
#pragma unroll
                for (int qq = 0; qq < 2; ++qq) { const int q = 2 * qp + qq; const int c0 = 64 * h + 32 * cb + 8 * q + 4 * hi; const int xo = 32 * cb + 8 * q;
                    const u32x2 r2 = *(const LAS u32x2*)(xs + xo), k2 = *(const LAS u32x2*)(xs + 256 + xo), v2 = *(const LAS u32x2*)(xs + 512 + xo);
                    const f32x4 kkp = *(const LAS f32x4*)(PAR + 512 + c0), kap = *(const LAS f32x4*)(PAR + 768 + c0);
                    const float rr[4] = {bflo(r2.x), bfhi(r2.x), bflo(r2.y), bfhi(r2.y)}, kr[4] = {bflo(k2.x), bfhi(k2.x), bflo(k2.y), bfhi(k2.y)};
                    float oa[4], obb[4], ok_[4], orr[4];
#pragma unroll
                    for (int i = 0; i < 4; ++i) { const int r = 4 * q + i; const float a = aa[cb][r], kk = kr[i] * kkp[i] * rn, km = kr[i] * (1.0f + (a - 1.0f) * kap[i]);
                        const float gam = __expf(cum[cb][r]), gprev = __expf(cum[cb][r] - aw[cb][r]), ig = __expf(-cum[cb][r]);
                        oa[i] = ok ? -gprev * kk : 0.f; obb[i] = ok ? kk * a * ig : 0.f; ok_[i] = ok ? km * ig : 0.f; orr[i] = ok ? gam * rr[i] : 0.f; }
                    wa[qq].x = pkbf(oa[0], oa[1]); wa[qq].y = pkbf(oa[2], oa[3]); wb[qq].x = pkbf(obb[0], obb[1]); wb[qq].y = pkbf(obb[2], obb[3]);
                    wk[qq].x = pkbf(ok_[0], ok_[1]); wk[qq].y = pkbf(ok_[2], ok_[3]); wr[qq].x = pkbf(orr[0], orr[1]); wr[qq].y = pkbf(orr[2], orr[3]);
                    wv[qq] = ok ? v2 : (u32x2){0u, 0u}; }
                const size_t o = obase + TM(t, 32 * cb + 16 * qp + 8 * hi);
                *(u32x4*)(ATg + o) = pair16(wa[0], wa[1]); *(u32x4*)(BTg + o) = pair16(wb[0], wb[1]); *(u32x4*)(KTg + o) = pair16(wk[0], wk[1]);
                *(u32x4*)(RTg + o) = pair16(wr[0], wr[1]); *(u32x4*)(VVg + o) = pair16(wv[0], wv[1]); }
    }
    __syncthreads();
}

constexpr int R2_P = 144, R2_MB = 64 * R2_P;
typedef f32x16 M64[2][2];
#define R2_ZERO(M) do { _Pragma("unroll") for (int _a = 0; _a < 2; ++_a) _Pragma("unroll") for (int _b = 0; _b < 2; ++_b) _Pragma("unroll") for (int _r = 0; _r < 16; ++_r) M[_a][_b][_r] = 0.f; } while (0)
#define R2_MM_GG(M, Lg, Rg) do { bf16x8 _a[4][2], _b[4][2];     \
        _Pragma("unroll") for (int _ks = 0; _ks < 4; ++_ks) _Pragma("unroll") for (int _x = 0; _x < 2; ++_x) { \
            _a[_ks][_x] = *(const bf16x8*)((Lg) + TM(32 * _x + l31, 16 * _ks + 8 * hi)); _b[_ks][_x] = *(const bf16x8*)((Rg) + TM(32 * _x + l31, 16 * _ks + 8 * hi)); } \
        asm volatile("" ::: "memory"); \
        _Pragma("unroll") for (int _ks = 0; _ks < 4; ++_ks) _Pragma("unroll") for (int _rb = 0; _rb < 2; ++_rb) _Pragma("unroll") for (int _cb = 0; _cb < 2; ++_cb) \
            M[_rb][_cb] = __builtin_amdgcn_mfma_f32_32x32x16_bf16(_a[_ks][_rb], _b[_ks][_cb], M[_rb][_cb], 0, 0, 0); } while (0)
#define R2_MM_LP(M, buf, Bpk) do { asm volatile("" ::: "memory"); _Pragma("unroll") for (int _ks = 0; _ks < 4; ++_ks) _Pragma("unroll") for (int _rb = 0; _rb < 2; ++_rb) { \
        const bf16x8 _a = *(const LAS bf16x8*)((buf) + (32 * _rb + l31) * R2_P + (16 * _ks + 8 * hi) * 2); \
        _Pragma("unroll") for (int _cb = 0; _cb < 2; ++_cb) M[_rb][_cb] = __builtin_amdgcn_mfma_f32_32x32x16_bf16(_a, Bpk[_ks][_cb], M[_rb][_cb], 0, 0, 0); } } while (0)
#define R2_PACK(Bpk, M) do { _Pragma("unroll") for (int _ks = 0; _ks < 4; ++_ks) _Pragma("unroll") for (int _cb = 0; _cb < 2; ++_cb) Bpk[_ks][_cb] = pack_acc(M[_ks >> 1][_cb], _ks & 1); } while (0)
#define R2_TO_LDS(buf, M) do { asm volatile("" ::: "memory"); _Pragma("unroll") for (int _rb = 0; _rb < 2; ++_rb) _Pragma("unroll") for (int _cb = 0; _cb < 2; ++_cb) _Pragma("unroll") for (int _r = 0; _r < 16; _r += 2) { \
        const unsigned _w = pkbf(M[_rb][_cb][_r], M[_rb][_cb][_r + 1]); LAS unsigned char* _a = (buf) + (32 * _rb + (_r & 3) + 8 * (_r >> 2) + 4 * hi) * R2_P + kperm(32 * _cb + l31) * 2; \
        *(LAS bf16_t*)_a = (bf16_t)_w; *(LAS bf16_t*)(_a + R2_P) = (bf16_t)(_w >> 16); } asm volatile("" ::: "memory"); } while (0)
#define R2_MASK(M, STRICT) do { _Pragma("unroll") for (int _rb = 0; _rb < 2; ++_rb) _Pragma("unroll") for (int _cb = 0; _cb < 2; ++_cb) _Pragma("unroll") for (int _r = 0; _r < 16; ++_r) { \
        const int _row = 32 * _rb + (_r & 3) + 8 * (_r >> 2) + 4 * hi, _col = 32 * _cb + l31; if (STRICT ? !(_row < _col) : !(_row <= _col)) M[_rb][_cb][_r] = 0.f; } } while (0)
#define R2_PSEUDO(Bpk, Xg) do { _Pragma("unroll") for (int _ks = 0; _ks < 4; ++_ks) _Pragma("unroll") for (int _cb = 0; _cb < 2; ++_cb) { unsigned _w[4]; \
        _Pragma("unroll") for (int _e = 0; _e < 8; _e += 2) { const int _t = 16 * _ks + 8 * (_e >> 2) + 4 * hi + (_e & 3); \
            _w[_e >> 1] = (unsigned)(Xg)[TM(_t, 32 * _cb + l31)] | ((unsigned)(Xg)[TM(_t + 1, 32 * _cb + l31)] << 16); } \
        u32x4 _v; _v.x = _w[0]; _v.y = _w[1]; _v.z = _w[2]; _v.w = _w[3]; Bpk[_ks][_cb] = __builtin_bit_cast(bf16x8, _v); } } while (0)
#define R2_TRANS(buf, Xg) do { asm volatile("" ::: "memory"); _Pragma("unroll") for (int _q = 0; _q < 8; ++_q) { unsigned _w[4]; \
        _Pragma("unroll") for (int _e = 0; _e < 8; _e += 2) _w[_e >> 1] = (unsigned)(Xg)[TM(kperm(8 * _q + _e), lane)] | ((unsigned)(Xg)[TM(kperm(8 * _q + _e + 1), lane)] << 16); \
        u32x4 _v; _v.x = _w[0]; _v.y = _w[1]; _v.z = _w[2]; _v.w = _w[3]; *(LAS u32x4*)((buf) + lane * R2_P + _q * 16) = _v; } asm volatile("" ::: "memory"); } while (0)
#define R2_RAW(buf, Xg) do { u32x4 _p[8]; _Pragma("unroll") for (int _q = 0; _q < 8; ++_q) _p[_q] = *(const u32x4*)((Xg) + (64 * _q + lane) * 8); \
        asm volatile("" ::: "memory"); _Pragma("unroll") for (int _q = 0; _q < 8; ++_q) { const int _pp = 64 * _q + lane; \
            *(LAS u32x4*)((buf) + ((_pp >> 1) & 63) * R2_P + (16 * (_pp >> 7) + 8 * (_pp & 1)) * 2) = _p[_q]; } asm volatile("" ::: "memory"); } while (0)
#define R2_RD16(raw, t, j) ((unsigned)*(const LAS unsigned short*)((raw) + (t) * R2_P + (j) * 2))
#define R2_TRANS_L(img, raw) do { asm volatile("" ::: "memory"); _Pragma("unroll") for (int _q = 0; _q < 8; ++_q) { unsigned _w[4]; \
        _Pragma("unroll") for (int _e = 0; _e < 8; _e += 2) _w[_e >> 1] = R2_RD16(raw, kperm(8 * _q + _e), lane) | (R2_RD16(raw, kperm(8 * _q + _e + 1), lane) << 16); \
        u32x4 _v; _v.x = _w[0]; _v.y = _w[1]; _v.z = _w[2]; _v.w = _w[3]; *(LAS u32x4*)((img) + lane * R2_P + _q * 16) = _v; } asm volatile("" ::: "memory"); } while (0)
#define R2_PSEUDO_L(Bpk, raw) do { asm volatile("" ::: "memory"); _Pragma("unroll") for (int _ks = 0; _ks < 4; ++_ks) _Pragma("unroll") for (int _cb = 0; _cb < 2; ++_cb) { unsigned _w[4]; \
        _Pragma("unroll") for (int _e = 0; _e < 8; _e += 2) { const int _t = 16 * _ks + 8 * (_e >> 2) + 4 * hi + (_e & 3); \
            _w[_e >> 1] = R2_RD16(raw, _t, 32 * _cb + l31) | (R2_RD16(raw, _t + 1, 32 * _cb + l31) << 16); } \
        u32x4 _v; _v.x = _w[0]; _v.y = _w[1]; _v.z = _w[2]; _v.w = _w[3]; Bpk[_ks][_cb] = __builtin_bit_cast(bf16x8, _v); } asm volatile("" ::: "memory"); } while (0)
#define R2_STORE_T(dst, M, PERM, SC) do { _Pragma("unroll") for (int _rb = 0; _rb < 2; ++_rb) _Pragma("unroll") for (int _cb = 0; _cb < 2; ++_cb) _Pragma("unroll") for (int _qp = 0; _qp < 2; ++_qp) { \
        u32x2 _w[2]; _Pragma("unroll") for (int _qq = 0; _qq < 2; ++_qq) { const int _q = 2 * _qp + _qq; \
            _w[_qq].x = pkbf(M[_rb][_cb][4 * _q] * (SC), M[_rb][_cb][4 * _q + 1] * (SC)); _w[_qq].y = pkbf(M[_rb][_cb][4 * _q + 2] * (SC), M[_rb][_cb][4 * _q + 3] * (SC)); } \
        if (PERM) { u32x4 _v; _v.x = _w[0].x; _v.y = _w[0].y; _v.z = _w[1].x; _v.w = _w[1].y; *(u32x4*)((dst) + TM(32 * _cb + l31, 32 * _rb + 16 * _qp + 8 * hi)) = _v; } \
        else *(u32x4*)((dst) + TM(32 * _cb + l31, 32 * _rb + 16 * _qp + 8 * hi)) = pair16(_w[0], _w[1]); } } while (0)

__device__ __forceinline__ void ph_rwkv_chunk(const Params& p, int l, LAS unsigned char* lds, const int wvid) {
    const int bid = lt_bid(); unsigned char* const ws = lt_ptr(p.ws); unsigned char* const ob = lt_ptr((unsigned char*)p.out);
    const int wave = __builtin_amdgcn_readfirstlane(lt_tid(wvid) >> 6);
    LAS unsigned char* X = lds + wave * (2 * R2_MB); LAS unsigned char* Y = X + R2_MB;
    for (int rnd = 0; rnd < 2; ++rnd) {
        const int unit = rnd == 0 ? bid * NWAVE + wave : (((bid & 7) == 0 && wave == 0) ? (int)gridDim.x * NWAVE + (bid >> 3) : RUN);
        if (unit >= RUN) continue;
        int lane = lt_tid(wvid) & 63, l31 = lane & 31, hi = lane >> 5;
#define R2_RELANE() do { lane = lt_tid(wvid) & 63; l31 = lane & 31; hi = lane >> 5; } while (0)
        const size_t uo = (size_t)unit * 4096;
        const bf16_t* ATg = (const bf16_t*)(ob + RO_AT) + uo; const bf16_t* BTg = (const bf16_t*)(ob + RO_BT) + uo; const bf16_t* KTg = (const bf16_t*)(ob + RO_KT) + uo;
        const bf16_t* RTg = (const bf16_t*)(ob + RO_RT) + uo; const bf16_t* VVg = (const bf16_t*)(ob + RO_VV) + uo;
        bf16_t* PTg = (bf16_t*)(ob + RO_PT) + uo; bf16_t* QTg = (bf16_t*)(ob + RO_QT) + uo; bf16_t* GTg = (bf16_t*)(ws + WS_RWB + RW_GT) + uo; bf16_t* YLg = (bf16_t*)(ws + WS_RWB + RW_YL) + uo;
        const float gc0 = ((const float*)(ws + WS_RWB + RW_GC))[(size_t)unit * 64 + l31], gc1 = ((const float*)(ws + WS_RWB + RW_GC))[(size_t)unit * 64 + 32 + l31];
        bf16x8 Tpk[4][2], ABR[4][2];
        {
            M64 A; R2_ZERO(A); R2_MM_GG(A, BTg, ATg); R2_MASK(A, true);
            M64 Tm;
#pragma unroll
            for (int rb = 0; rb < 2; ++rb)
#pragma unroll
                for (int cb = 0; cb < 2; ++cb)
#pragma unroll
                    for (int r = 0; r < 16; ++r) Tm[rb][cb][r] = A[rb][cb][r] + ((rb == cb && ((r & 3) + 8 * (r >> 2) + 4 * hi) == l31) ? 1.f : 0.f);
            bf16x8 Apk[4][2];
            R2_TO_LDS(X, A); R2_PACK(Apk, A);
#pragma unroll 1
            for (int it = 0; it < 5; ++it) {
                { M64 A2; R2_ZERO(A2); R2_MM_LP(A2, X, Apk);
                  asm volatile("" ::: "memory");
                  R2_TO_LDS(X, A2); R2_PACK(Apk, A2); }
                R2_PACK(Tpk, Tm);
                R2_MM_LP(Tm, X, Tpk);
                asm volatile("" ::: "memory");
            }
            R2_PACK(Tpk, Tm);
        }
        {
            R2_RAW(X, ATg); R2_TRANS_L(Y, X);
            M64 W; R2_ZERO(W); R2_MM_LP(W, Y, Tpk);
            R2_TO_LDS(X, W);
        }
        R2_RELANE();
        {
            M64 B; R2_ZERO(B); R2_MM_GG(B, BTg, RTg); R2_MASK(B, false); R2_PACK(ABR, B);
        }
        {
            M64 G;
#pragma unroll
            for (int rb = 0; rb < 2; ++rb)
#pragma unroll
                for (int cb = 0; cb < 2; ++cb)
#pragma unroll
                    for (int q = 0; q < 4; ++q) { const u32x2 w = *(const u32x2*)(RTg + TM(32 * cb + l31, 32 * rb + 8 * q + 4 * hi));
                        G[rb][cb][4 * q] = bflo(w.x); G[rb][cb][4 * q + 1] = bfhi(w.x); G[rb][cb][4 * q + 2] = bflo(w.y); G[rb][cb][4 * q + 3] = bfhi(w.y); }
            R2_MM_LP(G, X, ABR);
            R2_STORE_T(GTg, G, true, 1.0f);
        }
        {
            bf16x8 Bp[4][2]; R2_RAW(Y, BTg); R2_PSEUDO_L(Bp, Y);
            M64 P; R2_ZERO(P); R2_MM_LP(P, X, Bp);
#pragma unroll
            for (int rb = 0; rb < 2; ++rb)
#pragma unroll
                for (int r = 0; r < 16; ++r) if (((r & 3) + 8 * (r >> 2) + 4 * hi) == l31) P[rb][rb][r] += 1.f;
#pragma unroll
            for (int rb = 0; rb < 2; ++rb)
#pragma unroll
                for (int r = 0; r < 16; ++r) { P[rb][0][r] *= gc0; P[rb][1][r] *= gc1; }
            R2_STORE_T(PTg, P, true, 1.0f);
        }
        R2_RELANE();
        bf16x8 Zpk[4][2];
        {
            M64 A; R2_ZERO(A); R2_MM_GG(A, KTg, ATg); R2_MASK(A, true);
            asm volatile("" ::: "memory");
            R2_TO_LDS(X, A);
            M64 Z; R2_ZERO(Z); R2_MM_LP(Z, X, Tpk); R2_PACK(Zpk, Z);
        }
        {
            R2_RAW(X, VVg); R2_TRANS_L(Y, X);
            M64 W; R2_ZERO(W); R2_MM_LP(W, Y, Zpk);
            asm volatile("" ::: "memory");
            R2_TO_LDS(X, W);
        }
        R2_RELANE();
        {
            bf16x8 AKR[4][2];
            { M64 B; R2_ZERO(B); R2_MM_GG(B, KTg, RTg); R2_MASK(B, false); R2_PACK(AKR, B); }
            M64 Yl; R2_ZERO(Yl); R2_MM_LP(Yl, X, ABR); R2_MM_LP(Yl, Y, AKR);
            R2_STORE_T(YLg, Yl, false, 1.0f);
        }
        R2_RELANE();
        {
            M64 Q; R2_ZERO(Q);
            { bf16x8 Bp[4][2]; R2_PSEUDO(Bp, BTg); R2_MM_LP(Q, X, Bp); }
            { bf16x8 Kp[4][2]; asm volatile("" ::: "memory"); R2_RAW(X, KTg); R2_PSEUDO_L(Kp, X); R2_MM_LP(Q, Y, Kp); }
#pragma unroll
            for (int rb = 0; rb < 2; ++rb)
#pragma unroll
                for (int r = 0; r < 16; ++r) { Q[rb][0][r] *= gc0; Q[rb][1][r] *= gc1; }
            R2_STORE_T(QTg, Q, false, 1.0f);
        }
        asm volatile("" ::: "memory");
    }
    if (l == 0) tr_in_rwkv_idle<6>(p, ws, lds, bid, wvid);
    asm volatile("s_waitcnt vmcnt(0)" ::: "memory");
    __syncthreads();
    if (lt_tid(wvid) == 0) { __builtin_amdgcn_fence(__ATOMIC_RELEASE, "agent"); asm volatile("s_waitcnt vmcnt(0)" ::: "memory");
        __hip_atomic_fetch_add((unsigned*)(ws + WS_CTL) + CW_R2D + l * 64, 1u, __ATOMIC_RELAXED, __HIP_MEMORY_SCOPE_AGENT); }
}

__device__ __forceinline__ void r4_zero_state(const Params& p, int l, unsigned char* ws, unsigned char* ob, int bh, int lane) {
    const int l31 = lane & 31, hi = lane >> 5, b = bh >> 2, h = bh & 3;
    const size_t uo = (size_t)bh * RCH * 4096;
    const bf16_t* YLg = (const bf16_t*)(ws + WS_RWB + RW_YL) + uo; const bf16_t* VVg = (const bf16_t*)(ob + RO_VV) + uo;
    const bf16_t* Gg = (const bf16_t*)(ws + WS_RWB + RW_G); const float* BCg = (const float*)(ws + WS_RWB + RW_BC); bf16_t* MIX = (bf16_t*)(ws + WS_MIX);
    const float lg0 = p.in[I_LNXG][l * 256 + h * 64 + l31], lg1 = p.in[I_LNXG][l * 256 + h * 64 + 32 + l31], lb0 = p.in[I_LNXB][l * 256 + h * 64 + l31], lb1 = p.in[I_LNXB][l * 256 + h * 64 + 32 + l31];
#pragma unroll 1
    for (int rb = 0; rb < 2; ++rb) {
        unsigned short y0s[16], y1s[16], v0[16], v1[16], g0[16], g1[16]; float bcv[16];
#pragma unroll
        for (int r = 0; r < 16; ++r) { const int t = 32 * rb + (r & 3) + 8 * (r >> 2) + 4 * hi; const size_t row = (size_t)b * LT + t;
            y0s[r] = YLg[TM(t, l31)]; y1s[r] = YLg[TM(t, 32 + l31)]; v0[r] = VVg[TM(t, l31)]; v1[r] = VVg[TM(t, 32 + l31)];
            g0[r] = Gg[row * 256 + h * 64 + l31]; g1[r] = Gg[row * 256 + h * 64 + 32 + l31]; bcv[r] = BCg[row * 4 + h]; }
#pragma unroll
        for (int r = 0; r < 16; ++r) { const int t = 32 * rb + (r & 3) + 8 * (r >> 2) + 4 * hi; const size_t row = (size_t)b * LT + t;
            const float y0 = bf2f(y0s[r]), y1 = bf2f(y1s[r]);
            const float mean = half_sum32(y0 + y1) * (1.f / 64.f); const float d0 = y0 - mean, d1 = y1 - mean;
            const float var = half_sum32(d0 * d0 + d1 * d1) * (1.f / 64.f); const float rs = frsq(var + 64e-5f);
            const float o0 = (d0 * rs * lg0 + lb0 + bcv[r] * bf2f(v0[r])) * bf2f(g0[r]);
            const float o1 = (d1 * rs * lg1 + lb1 + bcv[r] * bf2f(v1[r])) * bf2f(g1[r]);
            MIX[row * D + M_C + h * 64 + l31] = f2bf(o0); MIX[row * D + M_C + h * 64 + 32 + l31] = f2bf(o1); }
    }
}
__device__ __forceinline__ void ph_rwkv_scan2(const Params& p, int l, LAS unsigned char* lds, int first_block, const int wvid) {
    const int bid = lt_bid(); unsigned char* const ob = lt_ptr((unsigned char*)p.out);
    const int tid = lt_tid(wvid), lane = tid & 63, wave = __builtin_amdgcn_readfirstlane(tid >> 6), l31 = lane & 31, hi = lane >> 5;
    const int sw = (bid - first_block) * 4 + wave;
    if (bid < first_block) return;
    {
        if (tid == 0) { unsigned* r2d = (unsigned*)(lt_ptr(p.ws) + WS_CTL) + CW_R2D + l * 64; unsigned sp = 0;
            while (__hip_atomic_load(r2d, __ATOMIC_RELAXED, __HIP_MEMORY_SCOPE_AGENT) < gridDim.x) { __builtin_amdgcn_s_sleep(2); if (++sp > (1u << 24)) break; }
            __builtin_amdgcn_fence(__ATOMIC_ACQUIRE, "agent"); asm volatile("s_waitcnt vmcnt(0)" ::: "memory"); }
        __syncthreads();
    }
    if (wave >= 4) {
        if ((int)gridDim.x * NWAVE == NB * 4 * 64 && wave < 6) r4_zero_state(p, l, lt_ptr(p.ws), ob, (bid - first_block) * 2 + (wave - 4), lane);
        return; }
    if (sw >= 64) return;
    const int bh = sw >> 1, ib = sw & 1;
    const bf16_t* PT = (const bf16_t*)(ob + RO_PT) + (size_t)bh * RCH * 4096; const bf16_t* QT = (const bf16_t*)(ob + RO_QT) + (size_t)bh * RCH * 4096;
    u32x4* SH = (u32x4*)(ob + RO_SH) + (size_t)bh * RCH * 512;
    bf16x8 Sp[4];
    { unsigned z; asm volatile("v_mov_b32 %0, 0" : "=v"(z));
#pragma unroll
      for (int ks = 0; ks < 4; ++ks) { u32x4 zz; zz.x = z; zz.y = z; zz.z = z; zz.w = z; Sp[ks] = __builtin_bit_cast(bf16x8, zz); } }
    bf16x8 Pf[2][4]; unsigned short Qi[2][16];
#define R3_LOAD(c) do { const bf16_t* _p = PT + (size_t)(c) * 4096; const bf16_t* _q = QT + (size_t)(c) * 4096; \
        _Pragma("unroll") for (int _jb = 0; _jb < 2; ++_jb) { _Pragma("unroll") for (int _ks = 0; _ks < 4; ++_ks) Pf[_jb][_ks] = *(const bf16x8*)(_p + TM(32 * _jb + l31, 16 * _ks + 8 * hi)); \
            _Pragma("unroll") for (int _r = 0; _r < 16; ++_r) Qi[_jb][_r] = _q[TM(32 * _jb + (_r & 3) + 8 * (_r >> 2) + 4 * hi, 32 * ib + l31)]; } } while (0)
    R3_LOAD(0);
    for (int c = 0; c < RCH; ++c) {
#pragma unroll
        for (int ks = 0; ks < 4; ++ks) SH[(size_t)c * 512 + (ib * 4 + ks) * 64 + lane] = __builtin_bit_cast(u32x4, Sp[ks]);
        if (c + 1 == RCH) break;
        f32x16 acc[2];
#pragma unroll
        for (int jb = 0; jb < 2; ++jb)
#pragma unroll
            for (int r = 0; r < 16; ++r) acc[jb][r] = bf2f(Qi[jb][r]);
        bf16x8 Pc[2][4];
#pragma unroll
        for (int jb = 0; jb < 2; ++jb)
#pragma unroll
            for (int ks = 0; ks < 4; ++ks) Pc[jb][ks] = Pf[jb][ks];
        if (c + 2 < RCH) R3_LOAD(c + 1);
#pragma unroll
        for (int ks = 0; ks < 4; ++ks)
#pragma unroll
            for (int jb = 0; jb < 2; ++jb) acc[jb] = __builtin_amdgcn_mfma_f32_32x32x16_bf16(Pc[jb][ks], Sp[ks], acc[jb], 0, 0, 0);
#pragma unroll
        for (int ks = 0; ks < 4; ++ks) Sp[ks] = pack_acc(acc[ks >> 1], ks & 1);
    }
#undef R3_LOAD
    asm volatile("s_waitcnt vmcnt(0)" ::: "memory");
    __builtin_amdgcn_fence(__ATOMIC_RELEASE, "agent"); asm volatile("s_waitcnt vmcnt(0)" ::: "memory");
    if (lane == 0) __hip_atomic_fetch_add((unsigned*)(lt_ptr(p.ws) + WS_CTL) + CW_SCD + l * 64, 1u, __ATOMIC_RELAXED, __HIP_MEMORY_SCOPE_AGENT);
}

__device__ __forceinline__ void ph_rwkv_out(const Params& p, int l, LAS unsigned char* lds, const int wvid) {
    const int bid = lt_bid(); unsigned char* const ws = lt_ptr(p.ws); unsigned char* const ob = lt_ptr((unsigned char*)p.out);
    const int wave = __builtin_amdgcn_readfirstlane(lt_tid(wvid) >> 6);
    bf16_t* MIX = (bf16_t*)(ws + WS_MIX);
    const bf16_t* Gg = (const bf16_t*)(ws + WS_RWB + RW_G); const float* BCg = (const float*)(ws + WS_RWB + RW_BC);
    {
        if (lt_tid(wvid) == 0) { unsigned* scd = (unsigned*)(ws + WS_CTL) + CW_SCD + l * 64; unsigned sp = 0;
            while (__hip_atomic_load(scd, __ATOMIC_RELAXED, __HIP_MEMORY_SCOPE_AGENT) < 64u) { __builtin_amdgcn_s_sleep(2); if (++sp > (1u << 24)) break; }
            __builtin_amdgcn_fence(__ATOMIC_ACQUIRE, "agent"); asm volatile("s_waitcnt vmcnt(0)" ::: "memory"); }
        __syncthreads();
    }
    const bool bal = (int)gridDim.x * NWAVE == NB * 4 * 64;
    for (int rnd = 0; rnd < (bal ? 1 : 2); ++rnd) {
        int unit = rnd == 0 ? bid * NWAVE + wave : (((bid & 7) == 0 && wave == 0) ? (int)gridDim.x * NWAVE + (bid >> 3) : RUN);
        if (unit >= RUN) continue;
        if (bal) unit = (unit >> 6) * RCH + 1 + (unit & 63);
        const int lane = lt_tid(wvid) & 63, l31 = lane & 31, hi = lane >> 5;
        const int bh = unit / RCH, ch = unit % RCH, b = bh >> 2, h = bh & 3, t0 = ch * 64;
        const size_t uo = (size_t)unit * 4096;
        const bf16_t* GTg = (const bf16_t*)(ws + WS_RWB + RW_GT) + uo; const bf16_t* YLg = (const bf16_t*)(ws + WS_RWB + RW_YL) + uo; const bf16_t* VVg = (const bf16_t*)(ob + RO_VV) + uo;
        const u32x4* SH = (const u32x4*)(ob + RO_SH) + (size_t)unit * 512;
        LAS unsigned char* X = lds + wave * (2 * R2_MB); LAS unsigned char* Y = X + R2_MB;
        R2_RAW(X, VVg); R2_RAW(Y, YLg);
        bf16x8 ga[4][2], sb[4][2]; unsigned short yl[2][2][16];
#pragma unroll
        for (int ks = 0; ks < 4; ++ks)
#pragma unroll
            for (int x = 0; x < 2; ++x) { ga[ks][x] = *(const bf16x8*)(GTg + TM(32 * x + l31, 16 * ks + 8 * hi)); sb[ks][x] = __builtin_bit_cast(bf16x8, SH[(x * 4 + ks) * 64 + lane]); }
#pragma unroll
        for (int rb = 0; rb < 2; ++rb)
#pragma unroll
            for (int cb = 0; cb < 2; ++cb)
#pragma unroll
                for (int r = 0; r < 16; ++r) yl[rb][cb][r] = (unsigned short)R2_RD16(Y, 32 * rb + (r & 3) + 8 * (r >> 2) + 4 * hi, 32 * cb + l31);
        M64 Yt;
#pragma unroll
        for (int rb = 0; rb < 2; ++rb)
#pragma unroll
            for (int cb = 0; cb < 2; ++cb)
#pragma unroll
                for (int r = 0; r < 16; ++r) Yt[rb][cb][r] = bf2f(yl[rb][cb][r]);
#pragma unroll
        for (int ks = 0; ks < 4; ++ks)
#pragma unroll
            for (int rb = 0; rb < 2; ++rb)
#pragma unroll
                for (int cb = 0; cb < 2; ++cb) Yt[rb][cb] = __builtin_amdgcn_mfma_f32_32x32x16_bf16(ga[ks][rb], sb[ks][cb], Yt[rb][cb], 0, 0, 0);
        const float lg0 = p.in[I_LNXG][l * 256 + h * 64 + l31], lg1 = p.in[I_LNXG][l * 256 + h * 64 + 32 + l31], lb0 = p.in[I_LNXB][l * 256 + h * 64 + l31], lb1 = p.in[I_LNXB][l * 256 + h * 64 + 32 + l31];
#pragma unroll
        for (int rb = 0; rb < 2; ++rb) {
            unsigned short v0[16], v1[16], g0[16], g1[16]; float bcv[16];
#pragma unroll
            for (int r = 0; r < 16; ++r) { const int t = 32 * rb + (r & 3) + 8 * (r >> 2) + 4 * hi; const int tg = min(t0 + t, LT - 1); const size_t row = (size_t)b * LT + tg;
                v0[r] = (unsigned short)R2_RD16(X, t, l31); v1[r] = (unsigned short)R2_RD16(X, t, 32 + l31); g0[r] = Gg[row * 256 + h * 64 + l31]; g1[r] = Gg[row * 256 + h * 64 + 32 + l31]; bcv[r] = BCg[row * 4 + h]; }
#pragma unroll
            for (int r = 0; r < 16; ++r) { const int t = 32 * rb + (r & 3) + 8 * (r >> 2) + 4 * hi, tg = t0 + t;
                const float y0 = Yt[rb][0][r], y1 = Yt[rb][1][r];
                const float mean = half_sum32(y0 + y1) * (1.f / 64.f); const float d0 = y0 - mean, d1 = y1 - mean;
                const float var = half_sum32(d0 * d0 + d1 * d1) * (1.f / 64.f); const float rs = frsq(var + 64e-5f);
                if (tg < LT) { const size_t row = (size_t)b * LT + tg;
                    const float o0 = (d0 * rs * lg0 + lb0 + bcv[r] * bf2f(v0[r])) * bf2f(g0[r]);
                    const float o1 = (d1 * rs * lg1 + lb1 + bcv[r] * bf2f(v1[r])) * bf2f(g1[r]);
                    MIX[row * D + M_C + h * 64 + l31] = f2bf(o0); MIX[row * D + M_C + h * 64 + 32 + l31] = f2bf(o1); } }
        }
    }
    __syncthreads();
}

__device__ __forceinline__ void ph_ln1(const Params& p, int l, LAS unsigned char* lds, const int wvid) {
    const int bid = lt_bid(); unsigned char* const ws = lt_ptr(p.ws); (void)bid; (void)ws;
    const int tid = lt_tid(wvid), lane = tid & 63, wave = tid >> 6, gw = bid * NWAVE + wave, NGW = gridDim.x * NWAVE;
    LAS float* rw = (LAS float*)lds;
    LAS float* LG = (LAS float*)(lds + 69632);
    LAS int* lcnt = (LAS int*)(lds + 65536); LAS int* lbase = lcnt + 16; LAS int* ent = lcnt + 32;
    __syncthreads();
    for (int i = tid; i < D * NE / 4; i += NTHR) { const f32x4 w = *(const f32x4*)(p.in[I_ROUTW] + 4 * i); const int c = i >> 2, e0 = (i & 3) * 4;
        rw[(e0 + 0) * D + c] = w[0]; rw[(e0 + 1) * D + c] = w[1]; rw[(e0 + 2) * D + c] = w[2]; rw[(e0 + 3) * D + c] = w[3]; }
    if (tid < 16) lcnt[tid] = 0;
    __syncthreads();
    const bf16_t* Z = (const bf16_t*)(ws + WS_Z); bf16_t* HB = (bf16_t*)(ws + WS_HB);
    unsigned* cnt = (unsigned*)(ws + WS_CTL) + CW_CNT + l * 16;
    int* TE = (int*)(ws + WS_TOKE); int* TP = (int*)(ws + WS_TOKP);
    const LnPar ln1 = ln_par(p.in[I_LN1G] + l * D, p.in[I_LN1B] + l * D, lane);
    int k = 0;
    u32x2 zn[4];
#pragma unroll
    for (int j = 0; j < 4; ++j) zn[j] = *(const u32x2*)(Z + (size_t)min(gw, T - 1) * D + 4 * lane + 256 * j);
    for (int r = gw; r < T; r += NGW, ++k) {
        f32x4 v[4]; u32x2 zc[4];
#pragma unroll
        for (int j = 0; j < 4; ++j) { zc[j] = zn[j]; zn[j] = *(const u32x2*)(Z + (size_t)min(r + NGW, T - 1) * D + 4 * lane + 256 * j); }
        if (r < MP - 256) {
#pragma unroll
            for (int j = 0; j < 4; ++j) { const u32x2 z = zc[j]; v[j] = (f32x4){bflo(z.x), bfhi(z.x), bflo(z.y), bfhi(z.y)}; }
        } else {
            const float* zp = (const float*)(ws + WS_ZP) + (size_t)(r - (MP - 256)) * D + 4 * lane;
#pragma unroll
            for (int j = 0; j < 4; ++j) { const u32x2 hh = *(const u32x2*)(HB + (size_t)r * D + 4 * lane + 256 * j); f32x4 a = (f32x4){ALPHA * bflo(hh.x), ALPHA * bfhi(hh.x), ALPHA * bflo(hh.y), ALPHA * bfhi(hh.y)};
#pragma unroll
                for (int k2 = 0; k2 < ZSPLIT; ++k2) a = a + *(const f32x4*)(zp + (size_t)k2 * 256 * D + 256 * j);
                v[j] = a; }
        }
        ln_affine(v, ln1);
        store_row_bf16(HB + (size_t)r * D, v, lane);
        float lg[16];
#pragma unroll
        for (int e = 0; e < 16; ++e) lg[e] = 0.f;
#pragma unroll
        for (int j = 0; j < 4; ++j)
#pragma unroll
            for (int e = 0; e < 16; ++e) { const f32x4 w = *(const LAS f32x4*)(rw + e * D + 256 * j + 4 * lane);
                lg[e] += (v[j][0] * w[0] + v[j][1] * w[1]) + (v[j][2] * w[2] + v[j][3] * w[3]); }
        { const bool b3 = lane & 8, b2 = lane & 4, b1 = lane & 2, b0 = lane & 1;
          float h8[8], h4[4], h2[2];
#pragma unroll
          for (int i = 0; i < 8; ++i) h8[i] = (b3 ? lg[i + 8] : lg[i]) + dpp_get<0x128>(b3 ? lg[i] : lg[i + 8]);
#pragma unroll
          for (int i = 0; i < 4; ++i) h4[i] = (b2 ? h8[i + 4] : h8[i]) + dpp_get<0x141>(b2 ? h8[i] : h8[i + 4]);
#pragma unroll
          for (int i = 0; i < 2; ++i) h2[i] = (b1 ? h4[i + 2] : h4[i]) + dpp_get<0x4E>(b1 ? h4[i] : h4[i + 2]);
          float x = (b0 ? h2[1] : h2[0]) + dpp_get<0xB1>(b0 ? h2[0] : h2[1]);
          x += __shfl_xor(x, 16); x += __shfl_xor(x, 32);
          if (lane < 16) LG[(wave * 20 + k) * 16 + lane] = x; }
    }
    float gt1 = 0.f, gt2 = 0.f;
    {
        const int nrow = k;
        if (lane < nrow) { const int r = gw + lane * NGW;
            float lgv[16];
#pragma unroll
            for (int q = 0; q < 4; ++q) { const f32x4 t4 = *(const LAS f32x4*)(LG + (wave * 20 + lane) * 16 + 4 * q); lgv[4 * q] = t4[0]; lgv[4 * q + 1] = t4[1]; lgv[4 * q + 2] = t4[2]; lgv[4 * q + 3] = t4[3]; }
            float sc[16], bi[16];
#pragma unroll
            for (int e = 0; e < 16; ++e) { sc[e] = sigmoidf_(lgv[e]); bi[e] = sc[e] + p.in[I_ROUTB][e]; }
            int bg = 0; float bgs = -1e30f;
#pragma unroll
            for (int g = 0; g < 4; ++g) { float m1 = -1e30f, m2 = -1e30f;
#pragma unroll
                for (int i = 0; i < 4; ++i) { const float x = bi[4 * g + i]; if (x > m1) { m2 = m1; m1 = x; } else if (x > m2) m2 = x; }
                const float s = m1 + m2; if (s > bgs) { bgs = s; bg = g; } }
            int i1 = 0, i2 = 0; float m1 = -1e30f, m2 = -1e30f, s1 = 0.f, s2 = 0.f;
#pragma unroll
            for (int g = 0; g < 4; ++g) { const bool on = g == bg;
#pragma unroll
                for (int i = 0; i < 4; ++i) { const float x = bi[4 * g + i]; if (on && x > m1) { m1 = x; i1 = 4 * g + i; s1 = sc[4 * g + i]; } }
#pragma unroll
                for (int i = 0; i < 4; ++i) { const float x = bi[4 * g + i]; if (on && 4 * g + i != i1 && x > m2) { m2 = x; i2 = 4 * g + i; s2 = sc[4 * g + i]; } }
            }
            const int p1 = __hip_atomic_fetch_add(lcnt + i1, 1, __ATOMIC_RELAXED, __HIP_MEMORY_SCOPE_WORKGROUP), p2 = __hip_atomic_fetch_add(lcnt + i2, 1, __ATOMIC_RELAXED, __HIP_MEMORY_SCOPE_WORKGROUP);
            ent[(wave * 20 + lane) * 2] = i1 | (p1 << 8); ent[(wave * 20 + lane) * 2 + 1] = i2 | (p2 << 8);
            const float inv = frcp(s1 + s2);
            *(int2*)(TE + 2 * r) = make_int2(i1, i2); gt1 = s1 * inv; gt2 = s2 * inv;
        }
    }
    __syncthreads();
    if (tid < 16) lbase[tid] = (int)atomicAdd(cnt + tid, (unsigned)lcnt[tid]);
    __syncthreads();
    { const int r = gw + lane * NGW; if (r < T) { const int e1 = ent[(wave * 20 + lane) * 2], e2 = ent[(wave * 20 + lane) * 2 + 1];
        const int p1 = lbase[e1 & 255] + (e1 >> 8), p2 = lbase[e2 & 255] + (e2 >> 8);
        *(int2*)(TP + 2 * r) = make_int2(p1, p2);
        int* LIST = (int*)(ws + WS_LIST); float* GSL = (float*)(ws + WS_GSL);
        LIST[(e1 & 255) * T + p1] = r; GSL[(e1 & 255) * T + p1] = gt1; LIST[(e2 & 255) * T + p2] = r; GSL[(e2 & 255) * T + p2] = gt2; } }
    __syncthreads();
}
__device__ __forceinline__ void ph_ln2(const Params& p, int l, LAS unsigned char* lds, const int wvid) {
    const int bid = lt_bid(); unsigned char* const ws = lt_ptr(p.ws); (void)bid; (void)ws;
    const int tid = lt_tid(wvid), lane = tid & 63, wave = tid >> 6, gw = bid * NWAVE + wave, NGW = gridDim.x * NWAVE;
    bf16_t* HB = (bf16_t*)(ws + WS_HB); const bf16_t* Y2 = (const bf16_t*)(ws + WS_Y2); const int* TE = (const int*)(ws + WS_TOKE); const int* TP = (const int*)(ws + WS_TOKP);
    LAS int* tab = (LAS int*)lds;
    moe_table(ws, l, tab, wvid);
    const LnPar ln2 = ln_par(p.in[I_LN2G] + l * D, p.in[I_LN2B] + l * D, lane);
    int sl0 = 0, sl1 = 0; { const int myr = gw + lane * NGW; if (myr < T) { const int2 ee = *(const int2*)(TE + 2 * myr), pp = *(const int2*)(TP + 2 * myr); sl0 = tab[17 + ee.x] + pp.x; sl1 = tab[17 + ee.y] + pp.y; } }
    int k = 0;
    for (int r = gw; r < T; r += 4 * NGW, k += 4) {
        u32x2 hv[4][4], av[4][4], cv[4][4]; bool on[4];
#pragma unroll
        for (int q = 0; q < 4; ++q) { const int rr = r + q * NGW; const int t = rr % LT; on[q] = rr < T && !(l == NLAYER - 1 && t < NMETA);
            const int rc = rr < T ? rr : gw; const int s0 = __builtin_amdgcn_readlane(sl0, k + q), s1 = __builtin_amdgcn_readlane(sl1, k + q);
#pragma unroll
            for (int j = 0; j < 4; ++j) { hv[q][j] = *(const u32x2*)(HB + (size_t)rc * D + 4 * lane + 256 * j); av[q][j] = *(const u32x2*)(Y2 + (size_t)s0 * D + 4 * lane + 256 * j); cv[q][j] = *(const u32x2*)(Y2 + (size_t)s1 * D + 4 * lane + 256 * j); } }
#pragma unroll
        for (int q = 0; q < 4; ++q) { const int rr = r + q * NGW; if (!on[q]) continue; const int b = rr / LT, t = rr % LT;
            f32x4 v[4];
#pragma unroll
            for (int j = 0; j < 4; ++j) { const u32x2 h = hv[q][j], a = av[q][j], c = cv[q][j];
                v[j][0] = ALPHA * bflo(h.x) + bflo(a.x) + bflo(c.x); v[j][1] = ALPHA * bfhi(h.x) + bfhi(a.x) + bfhi(c.x); v[j][2] = ALPHA * bflo(h.y) + bflo(a.y) + bflo(c.y); v[j][3] = ALPHA * bfhi(h.y) + bfhi(a.y) + bfhi(c.y); }
            ln_affine(v, ln2);
            if (l == NLAYER - 1) { float* o = p.out + ((size_t)b * SEQ + (t - NMETA)) * D;
#pragma unroll
                for (int j = 0; j < 4; ++j) *(f32x4*)(o + 4 * lane + 256 * j) = v[j]; }
            else store_row_bf16(HB + (size_t)rr * D, v, lane); }
    }
}

#define XB_TMO      128
#define XB_XCNT(j)  (256  + 64 * (j))
#define XB_XSUB(j)  (1280 + 64 * (j))
#define XB_XGEN(j)  (2304 + 64 * (j))
#define XB_TOP      3328
#define XB_TOPGEN   3392
#define XCD_BAR_WORDS 3456
#define XB_SPIN_CAP (1u << 22)

__device__ __forceinline__ unsigned xb_ld(unsigned* p)              { return __hip_atomic_load(p, __ATOMIC_RELAXED, __HIP_MEMORY_SCOPE_AGENT); }
__device__ __forceinline__ unsigned xb_add(unsigned* p, unsigned v) { return __hip_atomic_fetch_add(p, v, __ATOMIC_RELAXED, __HIP_MEMORY_SCOPE_AGENT); }
__device__ __forceinline__ unsigned xb_xcc_id() { return (unsigned)__builtin_amdgcn_s_getreg((3 << 11) | 20) & 0xFu; }
#define XB_SPIN(cond, bar) do { unsigned _sp = 0; while (cond) { __builtin_amdgcn_s_sleep(1); \
    if ((++_sp & 255u) == 0u) { if (xb_ld(&(bar)[XB_TMO])) break; if (_sp > XB_SPIN_CAP) { atomicAdd(&(bar)[XB_TMO], 1u); break; } } } } while (0)

struct XcdBarrier {
    unsigned* bar; unsigned x;
    volatile LAS unsigned* st;
};

__device__ __forceinline__ XcdBarrier xcd_barrier_post(unsigned* bar, volatile LAS unsigned* st) {
    XcdBarrier b; b.bar = bar; b.x = xb_xcc_id(); b.st = st;
    if (threadIdx.x == 0) (void)xb_add(&bar[XB_XCNT(b.x)], 1u);
    return b;
}
__device__ __forceinline__ void xcd_barrier_complete(unsigned* bar, unsigned x, unsigned& nloc, unsigned& nx) {
    const unsigned G = gridDim.x * gridDim.y * gridDim.z;
    unsigned sum, cnt, mine, sp = 0u;
    for (;;) {
        sum = 0u; cnt = 0u; mine = 0u;
#pragma unroll
        for (unsigned j = 0; j < 16; ++j) { const unsigned c = xb_ld(&bar[XB_XCNT(j)]); sum += c; cnt += (c > 0u) ? 1u : 0u; mine = (j == x) ? c : mine; }
        if (sum == G) break;
        __builtin_amdgcn_s_sleep(1);
        if ((++sp & 255u) == 0u) { if (xb_ld(&bar[XB_TMO])) break; if (sp > XB_SPIN_CAP) { atomicAdd(&bar[XB_TMO], 1u); break; } }
    }
    nloc = mine > 0u ? mine : 1u; nx = cnt > 0u ? cnt : 1u;
}

__device__ __forceinline__ void xcd_barrier(const XcdBarrier& b) {
    asm volatile("s_waitcnt vmcnt(0)" ::: "memory");
    __syncthreads();
    if (threadIdx.x == 0) {
        unsigned* bar = b.bar;
        __builtin_amdgcn_s_waitcnt(0);
        unsigned nloc = b.st[0], nx = b.st[1];
        if (nloc == 0u) { xcd_barrier_complete(bar, b.x, nloc, nx); b.st[0] = nloc; b.st[1] = nx; }
        const unsigned old = xb_add(&bar[XB_XSUB(b.x)], 1u);
        const unsigned gen = old / nloc;
        if (old + 1u == (gen + 1u) * nloc) {
            __builtin_amdgcn_fence(__ATOMIC_RELEASE, "agent");
            asm volatile("s_waitcnt vmcnt(0)" ::: "memory");
            const unsigned og = xb_add(&bar[XB_TOP], 1u);
            const unsigned tg = og / nx;
            if (og + 1u == (tg + 1u) * nx) xb_add(&bar[XB_TOPGEN], 1u);
            else XB_SPIN(xb_ld(&bar[XB_TOPGEN]) == tg, bar);
            __builtin_amdgcn_fence(__ATOMIC_ACQUIRE, "agent");
            xb_add(&bar[XB_XGEN(b.x)], 1u);
            asm volatile("s_waitcnt vmcnt(0)" ::: "memory");
        } else {
            XB_SPIN(xb_ld(&bar[XB_XGEN(b.x)]) == gen, bar);
            __builtin_amdgcn_fence(__ATOMIC_ACQUIRE, "agent");
            asm volatile("s_waitcnt vmcnt(0)" ::: "memory");
        }
    }
    __syncthreads();
}


enum { PH_PROLOGUE = 0, PH_GEMM_IN, PH_PREP, PH_R2, PH_ATTN, PH_R4, PH_GEMM_OUT, PH_LN1, PH_SCATTER, PH_GEMM1, PH_GEMM2, PH_LN2 };
template <int PH> __global__ void __launch_bounds__(NTHR, 2) k_phase(Params p, int l) {
    extern __shared__ __attribute__((aligned(16))) unsigned char smem[];
    LAS unsigned char* lds = (LAS unsigned char*)smem;
    const int wvid = __builtin_amdgcn_readfirstlane((int)threadIdx.x >> 6);
    if (PH == PH_PROLOGUE) ph_prologue(p, lds, wvid);
    if (PH == PH_GEMM_IN) ph_gemm_in(p, l, lds, wvid);
    if (PH == PH_PREP) { ph_vt(p, l, lds, wvid); ph_conv2(p, l, lds, wvid); ph_rwkv_prep2(p, l, lds, wvid); }
    if (PH == PH_R2) ph_rwkv_chunk(p, l, lds, wvid);
    if (PH == PH_ATTN) { ph_rwkv_scan2(p, l, lds, (int)gridDim.x - 16, wvid); ph_diff2(p, l, lds, wvid); ph_swa2(p, l, lds, wvid); }
    if (PH == PH_R4) ph_rwkv_out(p, l, lds, wvid);
    if (PH == PH_GEMM_OUT) ph_gemm_out(p, l, lds, wvid);
    if (PH == PH_LN1) ph_ln1(p, l, lds, wvid);
    if (PH == PH_GEMM1) ph_gemm1(p, l, lds, wvid);
    if (PH == PH_GEMM2) ph_gemm2(p, l, lds, wvid);
    if (PH == PH_LN2) ph_ln2(p, l, lds, wvid);
}


__global__ void __launch_bounds__(NTHR, 2) k_fused(Params p) {
    extern __shared__ __attribute__((aligned(16))) unsigned char smem[];
    LAS unsigned char* lds = (LAS unsigned char*)smem;
    const int wvid = __builtin_amdgcn_readfirstlane((int)threadIdx.x >> 6);
    volatile LAS unsigned* st = (volatile LAS unsigned*)(lds + LDS_BYTES - 16);
    if (threadIdx.x == 0) { st[0] = 0u; st[1] = 0u; st[2] = 0u; st[3] = 0u; }
    __syncthreads();
    (void)xcd_barrier_post((unsigned*)(p.ws + WS_CTL) + CW_BAR, st);
#define GRID_SYNC() do { XcdBarrier _b; _b.bar = (unsigned*)(lt_ptr(p.ws) + WS_CTL) + CW_BAR; _b.x = xb_xcc_id(); _b.st = st; xcd_barrier(_b); } while (0)
    ph_prologue(p, lds, wvid); GRID_SYNC();
    if (PROBE_DUP == 14) { ph_prologue(p, lds, wvid); GRID_SYNC(); }
    for (int l = 0; l < NLAYER; ++l) {
        ph_gemm_in(p, l, lds, wvid); GRID_SYNC();
        if (PROBE_DUP == 1) { ph_gemm_in(p, l, lds, wvid); GRID_SYNC(); }
        ph_vt(p, l, lds, wvid); ph_conv2(p, l, lds, wvid); ph_rwkv_prep2(p, l, lds, wvid); GRID_SYNC();
        if (PROBE_DUP == 2) { ph_vt(p, l, lds, wvid); GRID_SYNC(); }
        if (PROBE_DUP == 3) { ph_conv2(p, l, lds, wvid); GRID_SYNC(); }
        if (PROBE_DUP == 4) { ph_rwkv_prep2(p, l, lds, wvid); GRID_SYNC(); }
        ph_rwkv_chunk(p, l, lds, wvid);
        if (PROBE_DUP == 5 || PROBE_DUP == 6) GRID_SYNC();
        if (PROBE_DUP == 5) { ph_rwkv_chunk(p, l, lds, wvid); GRID_SYNC(); }
        ph_rwkv_scan2(p, l, lds, (int)gridDim.x - 16, wvid); ph_diff2(p, l, lds, wvid); ph_swa2(p, l, lds, wvid);
        if (PROBE_DUP >= 6 && PROBE_DUP <= 9) GRID_SYNC();
        if (PROBE_DUP == 6) { ph_rwkv_scan2(p, l, lds, (int)gridDim.x - 16, wvid); GRID_SYNC(); }
        if (PROBE_DUP == 7) { ph_diff2(p, l, lds, wvid, 1); GRID_SYNC(); }
        if (PROBE_DUP == 8) { ph_swa2(p, l, lds, wvid, 1); GRID_SYNC(); }
        ph_rwkv_out(p, l, lds, wvid); GRID_SYNC();
        if (PROBE_DUP == 9) { ph_rwkv_out(p, l, lds, wvid); GRID_SYNC(); }
        ph_gemm_out(p, l, lds, wvid); GRID_SYNC();
        if (PROBE_DUP == 10) { ph_gemm_out(p, l, lds, wvid); GRID_SYNC(); }
        ph_ln1(p, l, lds, wvid); GRID_SYNC();
        ph_gemm1(p, l, lds, wvid); GRID_SYNC();
        if (PROBE_DUP == 11) { ph_gemm1(p, l, lds, wvid); GRID_SYNC(); }
        ph_gemm2(p, l, lds, wvid); GRID_SYNC();
        if (PROBE_DUP == 12) { ph_gemm2(p, l, lds, wvid); GRID_SYNC(); }
        if (PROBE_DUP == 13) { GRID_SYNC(); GRID_SYNC(); GRID_SYNC(); GRID_SYNC(); GRID_SYNC(); GRID_SYNC(); GRID_SYNC(); GRID_SYNC(); GRID_SYNC(); GRID_SYNC(); }
        ph_ln2(p, l, lds, wvid); if (l + 1 < NLAYER) GRID_SYNC();
        if (PROBE_DUP == 16 && l + 1 == NLAYER) { GRID_SYNC(); ph_ln2(p, l, lds, wvid); GRID_SYNC(); ph_ln2(p, l, lds, wvid); }
    }
#undef GRID_SYNC
}

template <int PH> static void launch_phase(const Params& p, int l, int grid, hipStream_t stream) {
    static bool attr = false;
    if (!attr) { (void)hipFuncSetAttribute((const void*)k_phase<PH>, hipFuncAttributeMaxDynamicSharedMemorySize, LDS_BYTES); attr = true; }
    hipLaunchKernelGGL(k_phase<PH>, dim3(grid), dim3(NTHR), LDS_BYTES, stream, p, l);
}

extern "C" void kernel_launch(void* const* d_in, const int* in_sizes, int n_in, void* d_out, int out_size, void* d_ws, size_t ws_size, hipStream_t stream) {
    if (n_in != 37 || ws_size < WS_END) { fprintf(stderr, "kernel_launch: unexpected arguments (n_in %d, ws %zu, need %zu)\n", n_in, ws_size, (size_t)WS_END); return; }
    Params p{};
    for (int i = 0; i < 37; ++i) p.in[i] = (const float*)d_in[i];
    p.out = (float*)d_out; p.ws = (unsigned char*)d_ws;
    (void)hipMemsetAsync((char*)d_ws + WS_CTL, 0, CTL_BYTES, stream);
#if MK_ONE_LAUNCH
    static int grid = 0;
    if (!grid) {
        int dev = 0, cus = 0, per_cu = 0;
        (void)hipGetDevice(&dev); (void)hipDeviceGetAttribute(&cus, hipDeviceAttributeMultiprocessorCount, dev);
        (void)hipFuncSetAttribute((const void*)k_fused, hipFuncAttributeMaxDynamicSharedMemorySize, LDS_BYTES);
        (void)hipOccupancyMaxActiveBlocksPerMultiprocessor(&per_cu, (const void*)k_fused, NTHR, LDS_BYTES);
        if (per_cu < 1) fprintf(stderr, "kernel_launch: occupancy query reports %d workgroups per CU\n", per_cu);
        grid = cus > 0 ? cus : 256;
    }
    hipLaunchKernelGGL(k_fused, dim3(grid), dim3(NTHR), LDS_BYTES, stream, p);
#else
    const int grid = 256;
    launch_phase<PH_PROLOGUE>(p, 0, grid, stream);
    for (int l = 0; l < NLAYER; ++l) {
        launch_phase<PH_GEMM_IN>(p, l, grid, stream);
        launch_phase<PH_PREP>(p, l, grid, stream);
        launch_phase<PH_R2>(p, l, grid, stream);
        launch_phase<PH_ATTN>(p, l, grid, stream);
        launch_phase<PH_R4>(p, l, grid, stream);
        launch_phase<PH_GEMM_OUT>(p, l, grid, stream);
        launch_phase<PH_LN1>(p, l, grid, stream);
        launch_phase<PH_GEMM1>(p, l, grid, stream);
        launch_phase<PH_GEMM2>(p, l, grid, stream);
        launch_phase<PH_LN2>(p, l, grid, stream);
    }
#endif
}
```
